# Optimizing an MI355X kernel written in HIP

```python
import math
import jax, jax.numpy as jnp
from jax import lax
import numpy as np

D_MODEL = 1024
BATCH = 16
SEQ = 256
DEPTH = 4
DEC_BATCH = 8
DEC_SEQ = 2048
PAST_LEN = 256

GRID_W = 64
N_HEADS = 8
N_KV_HEADS = 2
HEAD_DIM = 64
ATTN_WIDTH = N_HEADS * HEAD_DIM
KV_WIDTH = N_KV_HEADS * HEAD_DIM
POOL_WIDTH = D_MODEL - ATTN_WIDTH
POOL_WINDOWS = (2, 4, 8, 16)
N_POOL_GROUPS = len(POOL_WINDOWS)
POOL_GROUP = POOL_WIDTH // N_POOL_GROUPS
FOURIER_WIDTH = D_MODEL // 4
N_FOURIER_GROUPS = 4
FOURIER_GROUP = FOURIER_WIDTH // N_FOURIER_GROUPS
CONV_WIDTH = D_MODEL - FOURIER_WIDTH
CONV_K = 3
D_FF = 2816
FFN_CONV_K = 3
ROPE_THETA = 10000.0
Q_BLOCK = 128
LN_EPS = 1e-6
RMS_EPS = 1e-6
N_EVEN = (DEPTH + 1) // 2
N_ODD = DEPTH // 2
N_ATTN_LAYERS = N_EVEN
IN_EVEN = ATTN_WIDTH + 2 * KV_WIDTH + POOL_WIDTH
IN_ODD = 3 * CONV_WIDTH + FOURIER_WIDTH
DEEPNORM_ALPHA = (2 * DEPTH) ** 0.25
DEEPNORM_BETA = (8 * DEPTH) ** -0.25

kernel_name = 'hybrid_diffusion_prefix_trunk_step'


def layer_norm(x, g=None, b=None):
    xf = x.astype(jnp.float32)
    mu = jnp.mean(xf, -1, keepdims=True)
    var = jnp.mean(jnp.square(xf - mu), -1, keepdims=True)
    y = (xf - mu) * lax.rsqrt(var + LN_EPS)
    if g is not None:
        y = y * g.astype(jnp.float32) + b.astype(jnp.float32)
    return y.astype(x.dtype)


def rms_norm(x, g):
    xf = x.astype(jnp.float32)
    y = xf * lax.rsqrt(jnp.mean(xf * xf, -1, keepdims=True) + RMS_EPS) * g.astype(jnp.float32)
    return y.astype(x.dtype)


def axial_rope_tables(L):
    rows = L // GRID_W
    row = jnp.repeat(jnp.arange(rows, dtype=jnp.float32), GRID_W)
    col = jnp.tile(jnp.arange(GRID_W, dtype=jnp.float32), rows)
    n_freq = HEAD_DIM // 4
    inv = 1.0 / (ROPE_THETA ** (jnp.arange(n_freq, dtype=jnp.float32) / n_freq))
    ang = jnp.concatenate([row[:, None] * inv, col[:, None] * inv], -1)
    return jnp.cos(ang), jnp.sin(ang)


def apply_rope(x, cos, sin):
    xp = x.astype(jnp.float32).reshape(x.shape[:-1] + (HEAD_DIM // 2, 2))
    x0, x1 = xp[..., 0], xp[..., 1]
    c = cos[None, :, None, :]
    s = sin[None, :, None, :]
    out = jnp.stack([x0 * c - x1 * s, x0 * s + x1 * c], -1)
    return out.reshape(x.shape).astype(x.dtype)


def block_attention(q, k, v):
    B, Lq = q.shape[0], q.shape[1]
    nb = Lq // Q_BLOCK
    G = N_HEADS // N_KV_HEADS
    qb = q.reshape(B, nb, Q_BLOCK, N_KV_HEADS, G, HEAD_DIM).transpose(1, 0, 2, 3, 4, 5)
    scale = HEAD_DIM ** -0.5

    def one_block(qblk):
        s = jnp.einsum('bqkgd,bskd->bkgqs', qblk, k).astype(jnp.float32) * scale
        p = jax.nn.softmax(s, axis=-1).astype(v.dtype)
        return jnp.einsum('bkgqs,bskd->bqkgd', p, v)

    o = lax.map(one_block, qb)
    return o.transpose(1, 0, 2, 3, 4, 5).reshape(B, Lq, ATTN_WIDTH)


def centred_mean_pool(u, w):
    B, L, C = u.shape
    cs = jnp.concatenate([jnp.zeros((B, 1, C), jnp.float32), jnp.cumsum(u.astype(jnp.float32), axis=1)], 1)
    t = jnp.arange(L)
    lo = jnp.clip(t - w // 2, 0, L)
    hi = jnp.clip(t + w // 2, 0, L)
    s = cs[:, hi] - cs[:, lo]
    cnt = (hi - lo).astype(jnp.float32)
    return (s / cnt[None, :, None]).astype(u.dtype)


def pool_mixer(p, w_pool, pool_scale):
    B, L, _ = p.shape
    grp = p.reshape(B, L, N_POOL_GROUPS, POOL_GROUP)
    pooled = jnp.stack([centred_mean_pool(grp[:, :, i], w) for i, w in enumerate(POOL_WINDOWS)], 2) - grp
    mixed = jnp.einsum('blgc,gcd->blgd', pooled, w_pool)
    return mixed.reshape(B, L, POOL_WIDTH) * pool_scale


def depthwise_conv(x, w, b):
    K = w.shape[0]
    pad = K // 2
    L = x.shape[1]
    xp = jnp.pad(x, ((0, 0), (pad, K - 1 - pad), (0, 0)))
    y = b
    for j in range(K):
        y = y + xp[:, j:j + L] * w[j]
    return y


def fourier_mix(f):
    B, L, _ = f.shape
    fg = f.reshape(B, L, N_FOURIER_GROUPS, FOURIER_GROUP).astype(jnp.float32)
    out = jnp.fft.fft2(fg, axes=(1, 3), norm='ortho').real
    return out.reshape(B, L, FOURIER_WIDTH).astype(f.dtype)


def even_mixer(u, w_in, q_g, k_g, w_pool, pool_scale, rope, ctx_k, ctx_v):
    B, L, _ = u.shape
    proj = u @ w_in
    o1 = ATTN_WIDTH
    o2 = o1 + KV_WIDTH
    o3 = o2 + KV_WIDTH
    q = rms_norm(proj[..., :o1].reshape(B, L, N_HEADS, HEAD_DIM), q_g)
    k = rms_norm(proj[..., o1:o2].reshape(B, L, N_KV_HEADS, HEAD_DIM), k_g)
    v = proj[..., o2:o3].reshape(B, L, N_KV_HEADS, HEAD_DIM)
    p = proj[..., o3:]
    if rope is None:
        attn = block_attention(q, k, v)
    else:
        cos, sin = rope
        qr = apply_rope(q, cos, sin)
        kr = apply_rope(k, cos, sin)
        attn = block_attention(qr, jnp.concatenate([kr, ctx_k], 1), jnp.concatenate([v, ctx_v], 1))
    pool = pool_mixer(p, w_pool, pool_scale)
    return jnp.concatenate([attn, pool], -1), k, v


def odd_mixer(u, w_in, conv_w, conv_b):
    proj = u @ w_in
    h = proj[..., :CONV_WIDTH]
    bg = proj[..., CONV_WIDTH:2 * CONV_WIDTH]
    cg = proj[..., 2 * CONV_WIDTH:3 * CONV_WIDTH]
    f = proj[..., 3 * CONV_WIDTH:]
    conv_out = bg * depthwise_conv(cg * h, conv_w, conv_b)
    return jnp.concatenate([conv_out, fourier_mix(f)], -1)


def conv_ffn(u, w_up, cw, cb, w_down):
    a, g = jnp.split(u @ w_up, 2, axis=-1)
    return (jax.nn.silu(depthwise_conv(a, cw, cb)) * g) @ w_down


def run_trunk(x, cond, ctx_k, ctx_v, w_ada, b_ada, w_in_even, q_norm_g, k_norm_g, w_pool, pool_scale,
              w_in_odd, conv_w, conv_b, w_out, w_up, ffn_conv_w, ffn_conv_b, w_down, ln_g, ln_b):
    is_latent = ctx_k is not None
    rope = axial_rope_tables(x.shape[1]) if is_latent else None
    new_k, new_v = [], []
    for l in range(DEPTH):
        ada = jax.nn.silu(cond) @ w_ada[l] + b_ada[l]
        sh1, sc1, g1, sh2, sc2, g2 = jnp.split(ada[:, None, :], 6, axis=-1)
        u = layer_norm(x) * (1 + sc1) + sh1
        if l % 2 == 0:
            e = l // 2
            m, k, v = even_mixer(u, w_in_even[e], q_norm_g[e], k_norm_g[e], w_pool[e], pool_scale[e], rope,
                                 ctx_k[:, e] if is_latent else None, ctx_v[:, e] if is_latent else None)
            if not is_latent:
                new_k.append(k)
                new_v.append(v)
        else:
            o = l // 2
            m = odd_mixer(u, w_in_odd[o], conv_w[o], conv_b[o])
        x = layer_norm(DEEPNORM_ALPHA * x + g1 * (m @ w_out[l]), ln_g[l, 0], ln_b[l, 0])
        u = layer_norm(x) * (1 + sc2) + sh2
        f = conv_ffn(u, w_up[l], ffn_conv_w[l], ffn_conv_b[l], w_down[l])
        x = layer_norm(DEEPNORM_ALPHA * x + g2 * f, ln_g[l, 1], ln_b[l, 1])
    return x, new_k, new_v


def setup_inputs(seed: int = 0) -> dict:
    key = jax.random.key(seed)
    ks = iter(jax.random.split(key, 32))

    def nrm(shape, scale):
        return jax.random.normal(next(ks), shape, jnp.float32) * scale

    D = D_MODEL
    return {
        'x_prompt': nrm((BATCH, SEQ, D), 1.0),
        'x_sample': nrm((DEC_BATCH, DEC_SEQ, D), 1.0),
        'cache_k': nrm((DEC_BATCH, N_ATTN_LAYERS, PAST_LEN, N_KV_HEADS, HEAD_DIM), 1.0),
        'cache_v': nrm((DEC_BATCH, N_ATTN_LAYERS, PAST_LEN, N_KV_HEADS, HEAD_DIM), 1.0),
        'c': nrm((DEC_BATCH, D), 1.0),
        'c_ctx': nrm((D,), 1.0),
        'w_ada': nrm((DEPTH, D, 6 * D), D ** -0.5),
        'b_ada': nrm((DEPTH, 6 * D), 0.02),
        'w_in_even': nrm((N_EVEN, D, IN_EVEN), D ** -0.5),
        'q_norm_g': 1.0 + nrm((N_EVEN, HEAD_DIM), 0.02),
        'k_norm_g': 1.0 + nrm((N_EVEN, HEAD_DIM), 0.02),
        'w_pool': nrm((N_EVEN, N_POOL_GROUPS, POOL_GROUP, POOL_GROUP), POOL_GROUP ** -0.5),
        'pool_scale': 1.0 + nrm((N_EVEN, POOL_WIDTH), 0.02),
        'w_in_odd': nrm((N_ODD, D, IN_ODD), D ** -0.5),
        'conv_w': nrm((N_ODD, CONV_K, CONV_WIDTH), CONV_K ** -0.5),
        'conv_b': nrm((N_ODD, CONV_WIDTH), 0.02),
        'w_out': nrm((DEPTH, D, D), D ** -0.5 * DEEPNORM_BETA),
        'w_up': nrm((DEPTH, D, 2 * D_FF), D ** -0.5),
        'ffn_conv_w': nrm((DEPTH, FFN_CONV_K, D_FF), FFN_CONV_K ** -0.5),
        'ffn_conv_b': nrm((DEPTH, D_FF), 0.02),
        'w_down': nrm((DEPTH, D_FF, D), D_FF ** -0.5 * DEEPNORM_BETA),
        'ln_g': 1.0 + nrm((DEPTH, 2, D), 0.02),
        'ln_b': nrm((DEPTH, 2, D), 0.02),
    }


def reference(x_prompt, x_sample, cache_k, cache_v, c, c_ctx, w_ada, b_ada, w_in_even, q_norm_g, k_norm_g,
              w_pool, pool_scale, w_in_odd, conv_w, conv_b, w_out, w_up, ffn_conv_w, ffn_conv_b, w_down,
              ln_g, ln_b):
    y_prompt, ks, vs = run_trunk(x_prompt, c_ctx[None, :], None, None, w_ada, b_ada, w_in_even, q_norm_g,
                                 k_norm_g, w_pool, pool_scale, w_in_odd, conv_w, conv_b, w_out, w_up,
                                 ffn_conv_w, ffn_conv_b, w_down, ln_g, ln_b)
    new_cache_k = jnp.stack(ks, 1)
    new_cache_v = jnp.stack(vs, 1)
    y_sample, _, _ = run_trunk(x_sample, c, cache_k, cache_v, w_ada, b_ada, w_in_even, q_norm_g, k_norm_g,
                               w_pool, pool_scale, w_in_odd, conv_w, conv_b, w_out, w_up, ffn_conv_w,
                               ffn_conv_b, w_down, ln_g, ln_b)
    return (y_prompt, y_sample, new_cache_k, new_cache_v)
```

```cpp
#include <hip/hip_runtime.h>
#include <hip/hip_cooperative_groups.h>
#include <cstdio>
namespace cg = cooperative_groups;

#ifndef PHMASK
#define PHMASK 0xffff
#endif
#define EN(b) ((PHMASK >> (b)) & 1)
#ifndef MULTI_LAUNCH
#define MULTI_LAUNCH 0
#endif

#define DI __device__ __forceinline__
#define LAS __attribute__((address_space(3)))
typedef unsigned short bf16_t;
typedef short bf16x8 __attribute__((ext_vector_type(8)));
typedef float f32x4 __attribute__((ext_vector_type(4)));
typedef float f32x2 __attribute__((ext_vector_type(2)));
typedef float f32x16 __attribute__((ext_vector_type(16)));
typedef unsigned u32x4 __attribute__((ext_vector_type(4)));
typedef unsigned u32x2 __attribute__((ext_vector_type(2)));
typedef __bf16 bf2_t __attribute__((ext_vector_type(2)));

constexpr int T = 20480, TC = 4096, DM = 1024;
constexpr int DFF = 2816;
constexpr int CH = 10240;
constexpr float ALPHA = 1.6817928305074292f;
constexpr float LN_EPS = 1e-6f, RMS_EPS = 1e-6f;
constexpr float QSCALE = 0.125f * 1.4426950408889634f;
constexpr size_t MiB = 1048576;
constexpr size_t OFF_XB = 0;
constexpr size_t OFF_R1 = 80 * MiB;
constexpr size_t OFF_GB = OFF_R1 + 55 * MiB;
constexpr size_t OFF_R2 = 190 * MiB;
constexpr size_t OFF_Q = OFF_R2, OFF_P = OFF_R2 + 20 * MiB, OFF_KC = OFF_R2 + 40 * MiB, OFF_VTC = OFF_R2 + 41 * MiB;
constexpr size_t OFF_HC = OFF_R2, OFF_BG = OFF_R2 + 30 * MiB, OFF_XTC = OFF_R2 + 60 * MiB, OFF_XTL = OFF_R2 + 64 * MiB;
constexpr size_t OFF_W = 270 * MiB;
constexpr size_t OFF_WIN = OFF_W, OFF_WOUT = OFF_W + 11 * MiB / 2, OFF_WUP = OFF_W + 15 * MiB / 2, OFF_WDN = OFF_W + 37 * MiB / 2;
constexpr size_t OFF_DFT = 294 * MiB;
constexpr size_t OFF_DFT256 = OFF_DFT + 16 * MiB;
constexpr size_t OFF_KVL = 311 * MiB;
constexpr size_t KVL_SZ = (size_t)8 * 2304 * 128 * 2;
constexpr size_t OFF_ADA = 329 * MiB;
constexpr size_t OFF_ROPE = 330 * MiB;
constexpr size_t WS_END = 331 * MiB;
constexpr int LDS_BYTES = 131072;
constexpr int NPH = 2 + 4 * 11;

struct Params { const float* in[23]; float* out; unsigned char* ws; int ph_lo, ph_hi; };
struct Ctx { int tid, c, G; };

DI unsigned pk(float lo, float hi) { f32x2 v = {lo, hi}; return __builtin_bit_cast(unsigned, __builtin_convertvector(v, bf2_t)); }
DI float bflo(unsigned u) { return __uint_as_float(u << 16); }
DI float bfhi(unsigned u) { return __uint_as_float(u & 0xffff0000u); }
DI u32x2 pk4(f32x4 v) { u32x2 r; r.x = pk(v[0], v[1]); r.y = pk(v[2], v[3]); return r; }
DI f32x4 up4(u32x2 u) { f32x4 r = {bflo(u.x), bfhi(u.x), bflo(u.y), bfhi(u.y)}; return r; }
DI int cond_of(int row) { return row < TC ? 0 : 1 + ((row - TC) >> 11); }
DI float wsum(float v) {
#pragma unroll
    for (int o = 32; o > 0; o >>= 1) v += __shfl_xor(v, o);
    return v;
}

namespace pg8 {
constexpr int BM = 256, BK = 64, HALF = 128, HTB = HALF * BK * 2, STAGE_BYTES = 8 * HTB, NXCD = 8, WGM = 8;
DI int lds_byte(int r, int c) { const int st = (r >> 4) * 2 + (c >> 5), rr = r & 15, cc = c & 31, ob = rr * 64 + cc * 2; return st * 1024 + (ob ^ (((ob >> 9) & 1) << 5)); }
DI void stage_rc(int b, int& R, int& C) { const int st = b / 1024, sb = b % 1024, swz = sb ^ (((sb >> 9) & 1) << 5); R = (st >> 1) * 16 + swz / 64; C = (st & 1) * 32 + (swz % 64) / 2; }
struct Unit { int pm, pn; };
struct Gemm { const bf16_t* A; const bf16_t* Bt; int M, N, K; };
struct StaticOrder {
    int nM, nN, nwg, G, c;
    DI void init(int M, int N, int G_, int c_) { nM = M / BM; nN = N / BM; nwg = nM * nN; G = G_; c = c_; }
    DI bool next(int i, Unit& u) const {
        const long L = (long)i * G + c; if (L >= nwg) return false;
        int wgid = (int)L; { const int q = nwg / NXCD, r = nwg % NXCD, xcd = wgid % NXCD, off = wgid / NXCD; wgid = (xcd < r ? xcd * (q + 1) : r * (q + 1) + (xcd - r) * q) + off; }
        const int nig = WGM * nN, gid = wgid / nig, fm = gid * WGM, gsz = (nM - fm) < WGM ? (nM - fm) : WGM;
        u.pm = fm + ((wgid % nig) % gsz); u.pn = (wgid % nig) / gsz; return true;
    }
    DI void a_ready(const Unit&) const {}
    DI void done(const Unit&) const {}
};
struct OneUnit {
    int pm, pn, have;
    DI bool next(int i, Unit& u) const { if (i != 0 || !have) return false; u.pm = pm; u.pn = pn; return true; }
    DI void a_ready(const Unit&) const {}
    DI void done(const Unit&) const {}
};

template <class Epi, class Sched>
DI void gemm_phase(LAS unsigned char* lds, const Gemm g, const Sched& S, const Epi& E, const int tid) {
    const int wid = __builtin_amdgcn_readfirstlane(tid >> 6), lane = tid & 63, wr = wid >> 2, wc = wid & 3, fr = lane & 15, fq = lane >> 4;
    const int K = g.K, nt = K / BK;
    unsigned voffA[2], voffB[2];
#pragma unroll
    for (int i = 0; i < 2; ++i) { int R, C; stage_rc(tid * 16 + i * 8192, R, C); voffA[i] = (unsigned)(R * K + C) * 2u; voffB[i] = voffA[i]; }
    const size_t kstep = (size_t)(BK * 2);
    const size_t hstep = (size_t)HALF * K * 2;
    const size_t tstep = 2 * hstep;
    const unsigned ldsw = (unsigned)wid * 1024u;
    const int aoff = lds_byte(wr * 64 + fr, fq * 8), boff = lds_byte(wc * 32 + fr, fq * 8);
#define PG8_SA(b, h) (((b) * 2 + (h)) * HTB)
#define PG8_SB(b, h) ((4 + (b) * 2 + (h)) * HTB)
#define PG8_STAGE(bufoff, gbase, voff) do { _Pragma("unroll") for (int _i = 0; _i < 2; ++_i) \
        __builtin_amdgcn_global_load_lds((const unsigned*)((const char*)(gbase) + (voff)[_i]), (LAS unsigned*)(lds + (bufoff) + ldsw + _i * 8192), 16, 0, 0); } while (0)
#define PG8_LDA(dst, b, h) do { _Pragma("unroll") for (int m = 0; m < 4; ++m) _Pragma("unroll") for (int k = 0; k < 2; ++k) dst[m][k] = *(const LAS bf16x8*)(lds + PG8_SA(b, h) + aoff + m * 2048 + k * 1024); } while (0)
#define PG8_LDB(dst, b, h) do { _Pragma("unroll") for (int n = 0; n < 2; ++n) _Pragma("unroll") for (int k = 0; k < 2; ++k) dst[n][k] = *(const LAS bf16x8*)(lds + PG8_SB(b, h) + boff + n * 2048 + k * 1024); } while (0)
#define PG8_MMA(ai, bj, At, Bt) do { __builtin_amdgcn_s_setprio(1); _Pragma("unroll") for (int m = 0; m < 4; ++m) _Pragma("unroll") for (int n = 0; n < 2; ++n) _Pragma("unroll") for (int k = 0; k < 2; ++k) \
        acc[ai][bj][m][n] = __builtin_amdgcn_mfma_f32_16x16x32_bf16(Bt[n][k], At[m][k], acc[ai][bj][m][n], 0, 0, 0); __builtin_amdgcn_s_setprio(0); } while (0)
#define PG8_WAIT_V(n) asm volatile("s_waitcnt vmcnt(" #n ")" ::: "memory")
#define PG8_WAIT_L(n) asm volatile("s_waitcnt lgkmcnt(" #n ")" ::: "memory")
#define PG8_BAR __builtin_amdgcn_s_barrier()
#define PG8_SCHED __builtin_amdgcn_sched_barrier(0)
    Unit cur, nxt; int ui = 0;
    if (!S.next(0, cur)) return;
    f32x4 acc[2][2][4][2];
#pragma unroll
    for (int a = 0; a < 2; ++a)
#pragma unroll
        for (int b = 0; b < 2; ++b)
#pragma unroll
            for (int m = 0; m < 4; ++m)
#pragma unroll
                for (int n = 0; n < 2; ++n) acc[a][b][m][n] = (f32x4){0.f, 0.f, 0.f, 0.f};
    bf16x8 At[4][2], B0[2][2], B1[2][2];
    const char* cA = (const char*)g.A + (size_t)cur.pm * tstep; const char* cB = (const char*)g.Bt + (size_t)cur.pn * tstep;
    S.a_ready(cur);
    PG8_STAGE(PG8_SB(0, 0), cB, voffB); PG8_STAGE(PG8_SA(0, 0), cA, voffA); PG8_STAGE(PG8_SB(0, 1), cB + hstep, voffB); PG8_STAGE(PG8_SA(0, 1), cA + hstep, voffA);
    if (wr == 1) PG8_BAR;
    PG8_WAIT_V(4); PG8_BAR;
    PG8_STAGE(PG8_SB(1, 0), cB + kstep, voffB); PG8_STAGE(PG8_SA(1, 0), cA + kstep, voffA); PG8_STAGE(PG8_SB(1, 1), cB + hstep + kstep, voffB);
    PG8_WAIT_V(6); PG8_BAR;
    for (;;) {
        const bool has_next = S.next(ui + 1, nxt);
        const char* nA = has_next ? (const char*)g.A + (size_t)nxt.pm * tstep : cA; const char* nB = has_next ? (const char*)g.Bt + (size_t)nxt.pn * tstep : cB;
        for (int t = 0; t < nt; t += 2) {
            const bool last = (t == nt - 2);
            const char* a1 = cA + (size_t)(t + 1) * kstep;
            const char* a2 = last ? nA : cA + (size_t)(t + 2) * kstep; const char* b2 = last ? nB : cB + (size_t)(t + 2) * kstep;
            const char* a3 = a2 + kstep; const char* b3 = b2 + kstep;
            if (last && has_next) S.a_ready(nxt);
            PG8_LDB(B0, 0, 0); PG8_SCHED; PG8_LDA(At, 0, 0); PG8_STAGE(PG8_SA(1, 1), a1 + hstep, voffA);
            PG8_WAIT_L(8); PG8_BAR; PG8_WAIT_L(0); PG8_MMA(0, 0, At, B0); PG8_BAR; PG8_SCHED;
            PG8_LDB(B1, 0, 1); PG8_STAGE(PG8_SB(0, 0), b2, voffB);
            PG8_BAR; PG8_WAIT_L(0); PG8_MMA(0, 1, At, B1); PG8_BAR;
            PG8_LDA(At, 0, 1); PG8_STAGE(PG8_SA(0, 0), a2, voffA);
            PG8_BAR; PG8_WAIT_L(0); PG8_MMA(1, 0, At, B0); PG8_BAR; PG8_SCHED;
            PG8_STAGE(PG8_SB(0, 1), b2 + hstep, voffB);
            PG8_WAIT_V(6); PG8_BAR; PG8_MMA(1, 1, At, B1); PG8_BAR;
            PG8_LDB(B0, 1, 0); PG8_SCHED; PG8_LDA(At, 1, 0); PG8_STAGE(PG8_SA(0, 1), a2 + hstep, voffA);
            PG8_WAIT_L(8); PG8_BAR; PG8_WAIT_L(0); PG8_MMA(0, 0, At, B0); PG8_BAR; PG8_SCHED;
            PG8_LDB(B1, 1, 1); PG8_STAGE(PG8_SB(1, 0), b3, voffB);
            PG8_BAR; PG8_WAIT_L(0); PG8_MMA(0, 1, At, B1); PG8_BAR;
            PG8_LDA(At, 1, 1); PG8_STAGE(PG8_SA(1, 0), a3, voffA);
            PG8_BAR; PG8_WAIT_L(0); PG8_MMA(1, 0, At, B0); PG8_BAR; PG8_SCHED;
            PG8_STAGE(PG8_SB(1, 1), b3 + hstep, voffB);
            PG8_WAIT_V(6); PG8_BAR; PG8_MMA(1, 1, At, B1); PG8_BAR;
        }
        E(acc, cur, wr, wc, fr, fq); S.done(cur);
        if (!has_next) break;
#pragma unroll
        for (int a = 0; a < 2; ++a)
#pragma unroll
            for (int b = 0; b < 2; ++b)
#pragma unroll
                for (int m = 0; m < 4; ++m)
#pragma unroll
                    for (int n = 0; n < 2; ++n) acc[a][b][m][n] = (f32x4){0.f, 0.f, 0.f, 0.f};
        cur = nxt; cA = nA; cB = nB; ++ui;
    }
    PG8_WAIT_V(0);
    if (wr == 0) PG8_BAR;
    PG8_BAR;
#undef PG8_SA
#undef PG8_SB
#undef PG8_STAGE
#undef PG8_LDA
#undef PG8_LDB
#undef PG8_MMA
#undef PG8_WAIT_V
#undef PG8_WAIT_L
#undef PG8_BAR
#undef PG8_SCHED
}
}

typedef const f32x4 (&AccRef)[2][2][4][2];

struct EpiRes {
    const float* xc; const float* xl; float* y; const float* gate; int row_off;
    DI void operator()(AccRef acc, const pg8::Unit& u, int wr, int wc, int fr, int fq) const {
        const int col0 = u.pn * 256 + wc * 32 + 4 * fq;
#pragma unroll
        for (int ai = 0; ai < 2; ++ai)
#pragma unroll
            for (int m = 0; m < 4; ++m) {
                const int row = row_off + u.pm * 256 + ai * 128 + wr * 64 + m * 16 + fr;
                const float* xr = row < TC ? xc + (size_t)row * DM : xl + (size_t)(row - TC) * DM;
                const float* gr = gate + cond_of(row) * 6144;
                float* yr = y + (size_t)row * DM;
#pragma unroll
                for (int bj = 0; bj < 2; ++bj)
#pragma unroll
                    for (int n = 0; n < 2; ++n) {
                        const int c = col0 + bj * 128 + n * 16;
                        const f32x4 xv = *(const f32x4*)(xr + c), gv = *(const f32x4*)(gr + c);
                        *(f32x4*)(yr + c) = ALPHA * xv + gv * acc[ai][bj][m][n];
                    }
            }
    }
};

struct EpiEvenIn {
    bf16_t* Q; bf16_t* P; bf16_t* Kc; bf16_t* VTc; bf16_t* Kl; bf16_t* VTl; float* outk; float* outv;
    const float* qg; const float* kg; const float* rope; int e;
    DI void operator()(AccRef acc, const pg8::Unit& u, int wr, int wc, int fr, int fq) const {
        const int pn = u.pn;
        if (pn >= 3) {
#pragma unroll
            for (int ai = 0; ai < 2; ++ai)
#pragma unroll
                for (int m = 0; m < 4; ++m) {
                    const int row = u.pm * 256 + ai * 128 + wr * 64 + m * 16 + fr;
                    bf16_t* pr = P + (size_t)row * 512 + (pn - 3) * 256 + wc * 32 + 4 * fq;
#pragma unroll
                    for (int bj = 0; bj < 2; ++bj)
#pragma unroll
                        for (int n = 0; n < 2; ++n) *(u32x2*)(pr + bj * 128 + n * 16) = pk4(acc[ai][bj][m][n]);
                }
            return;
        }
        const bool is_v = (pn == 2 && wc >= 2);
        const float* gw = pn < 2 ? qg : kg;
#pragma unroll
        for (int ai = 0; ai < 2; ++ai)
#pragma unroll
            for (int m = 0; m < 4; ++m) {
                const int row = u.pm * 256 + ai * 128 + wr * 64 + m * 16 + fr;
                const bool latent = row >= TC;
                const int tpos = (row - TC) & 2047, b = (row - TC) >> 11;
                f32x4 v[2][2];
#pragma unroll
                for (int bj = 0; bj < 2; ++bj)
#pragma unroll
                    for (int n = 0; n < 2; ++n) v[bj][n] = acc[ai][bj][m][n];
                if (!is_v) {
                    float ss = 0.f;
#pragma unroll
                    for (int bj = 0; bj < 2; ++bj)
#pragma unroll
                        for (int n = 0; n < 2; ++n)
#pragma unroll
                            for (int j = 0; j < 4; ++j) ss += v[bj][n][j] * v[bj][n][j];
                    ss += __shfl_xor(ss, 16); ss += __shfl_xor(ss, 32);
                    const float rs = rsqrtf(ss * (1.0f / 64.0f) + RMS_EPS);
#pragma unroll
                    for (int bj = 0; bj < 2; ++bj)
#pragma unroll
                        for (int n = 0; n < 2; ++n) {
                            const int d = 32 * bj + 16 * n + 4 * fq;
                            const f32x4 g4 = *(const f32x4*)(gw + d);
                            v[bj][n] = v[bj][n] * rs * g4;
                            if (latent) {
                                const f32x4 cs = *(const f32x4*)(rope + ((size_t)tpos * 32 + (d >> 1)) * 2);
                                const float x0 = v[bj][n][0], x1 = v[bj][n][1], x2 = v[bj][n][2], x3 = v[bj][n][3];
                                v[bj][n][0] = x0 * cs[0] - x1 * cs[1]; v[bj][n][1] = x0 * cs[1] + x1 * cs[0];
                                v[bj][n][2] = x2 * cs[2] - x3 * cs[3]; v[bj][n][3] = x2 * cs[3] + x3 * cs[2];
                            }
                        }
                }
                if (pn < 2) {
                    bf16_t* qr = Q + (size_t)row * 512 + (pn * 4 + wc) * 64 + 4 * fq;
#pragma unroll
                    for (int bj = 0; bj < 2; ++bj)
#pragma unroll
                        for (int n = 0; n < 2; ++n) *(u32x2*)(qr + 32 * bj + 16 * n) = pk4(v[bj][n] * QSCALE);
                } else if (!is_v) {
                    const int h = wc;
                    if (!latent) {
                        const int bb = row >> 8, t = row & 255;
                        float* ok = outk + ((size_t)(bb * 2 + e) * 256 + t) * 128 + h * 64 + 4 * fq;
                        bf16_t* kr = Kc + (size_t)row * 128 + h * 64 + 4 * fq;
#pragma unroll
                        for (int bj = 0; bj < 2; ++bj)
#pragma unroll
                            for (int n = 0; n < 2; ++n) { *(f32x4*)(ok + 32 * bj + 16 * n) = v[bj][n]; *(u32x2*)(kr + 32 * bj + 16 * n) = pk4(v[bj][n]); }
                    } else {
                        bf16_t* kr = Kl + ((size_t)b * 2304 + tpos) * 128 + h * 64 + 4 * fq;
#pragma unroll
                        for (int bj = 0; bj < 2; ++bj)
#pragma unroll
                            for (int n = 0; n < 2; ++n) *(u32x2*)(kr + 32 * bj + 16 * n) = pk4(v[bj][n]);
                    }
                } else {
                    const int h = wc - 2;
                    if (!latent) {
                        const int bb = row >> 8, t = row & 255;
                        float* ov = outv + ((size_t)(bb * 2 + e) * 256 + t) * 128 + h * 64 + 4 * fq;
                        bf16_t* vr = VTc + ((size_t)(bb * 2 + h) * 64 + 4 * fq) * 256 + t;
#pragma unroll
                        for (int bj = 0; bj < 2; ++bj)
#pragma unroll
                            for (int n = 0; n < 2; ++n) {
                                *(f32x4*)(ov + 32 * bj + 16 * n) = v[bj][n];
                                const u32x2 pv = pk4(v[bj][n]);
                                bf16_t* vp = vr + (size_t)(32 * bj + 16 * n) * 256;
                                vp[0] = (bf16_t)(pv.x & 0xffff); vp[256] = (bf16_t)(pv.x >> 16); vp[512] = (bf16_t)(pv.y & 0xffff); vp[768] = (bf16_t)(pv.y >> 16);
                            }
                    } else {
                        bf16_t* vr = VTl + ((size_t)(b * 2 + h) * 64 + 4 * fq) * 2304 + tpos;
#pragma unroll
                        for (int bj = 0; bj < 2; ++bj)
#pragma unroll
                            for (int n = 0; n < 2; ++n) {
                                const u32x2 pv = pk4(v[bj][n]);
                                bf16_t* vp = vr + (size_t)(32 * bj + 16 * n) * 2304;
                                vp[0] = (bf16_t)(pv.x & 0xffff); vp[2304] = (bf16_t)(pv.x >> 16); vp[4608] = (bf16_t)(pv.y & 0xffff); vp[6912] = (bf16_t)(pv.y >> 16);
                            }
                    }
                }
                __builtin_amdgcn_sched_barrier(0);
            }
    }
};

struct EpiOddIn {
    bf16_t* HC; bf16_t* BG; bf16_t* XTc; bf16_t* XTl;
    DI void operator()(AccRef acc, const pg8::Unit& u, int wr, int wc, int fr, int fq) const {
        const int pn = u.pn;
#pragma unroll
        for (int ai = 0; ai < 2; ++ai)
#pragma unroll
            for (int m = 0; m < 4; ++m) {
                const int row = u.pm * 256 + ai * 128 + wr * 64 + m * 16 + fr;
                if (pn < 6) {
                    bf16_t* hr = HC + (size_t)row * 768 + pn * 128 + wc * 32 + 4 * fq;
#pragma unroll
                    for (int n = 0; n < 2; ++n) *(u32x2*)(hr + 16 * n) = pk4(acc[ai][0][m][n] * acc[ai][1][m][n]);
                } else if (pn < 9) {
                    bf16_t* br = BG + (size_t)row * 768 + (pn - 6) * 256 + wc * 32 + 4 * fq;
#pragma unroll
                    for (int bj = 0; bj < 2; ++bj)
#pragma unroll
                        for (int n = 0; n < 2; ++n) *(u32x2*)(br + bj * 128 + n * 16) = pk4(acc[ai][bj][m][n]);
                } else {
                    const int part = pn - 9;
                    bf16_t* xr; size_t cs;
                    if (row < TC) { const int bb = row >> 8, t = row & 255; cs = 512; xr = XTc + (size_t)bb * 256 * 512 + part * 256 + t; }
                    else { const int b = (row - TC) >> 11, t = (row - TC) & 2047; cs = 4096; xr = XTl + (size_t)b * 256 * 4096 + part * 2048 + t; }
#pragma unroll
                    for (int bj = 0; bj < 2; ++bj)
#pragma unroll
                        for (int n = 0; n < 2; ++n) {
                            const u32x2 pv = pk4(acc[ai][bj][m][n]);
                            bf16_t* xp = xr + (size_t)(bj * 128 + wc * 32 + n * 16 + 4 * fq) * cs;
                            xp[0] = (bf16_t)(pv.x & 0xffff); xp[cs] = (bf16_t)(pv.x >> 16); xp[2 * cs] = (bf16_t)(pv.y & 0xffff); xp[3 * cs] = (bf16_t)(pv.y >> 16);
                        }
                }
            }
    }
};

struct EpiUp {
    bf16_t* A; bf16_t* G;
    DI void operator()(AccRef acc, const pg8::Unit& u, int wr, int wc, int fr, int fq) const {
#pragma unroll
        for (int ai = 0; ai < 2; ++ai)
#pragma unroll
            for (int m = 0; m < 4; ++m) {
                const int row = u.pm * 256 + ai * 128 + wr * 64 + m * 16 + fr;
                const size_t o = (size_t)row * DFF + u.pn * 128 + wc * 32 + 4 * fq;
#pragma unroll
                for (int n = 0; n < 2; ++n) { *(u32x2*)(A + o + 16 * n) = pk4(acc[ai][0][m][n]); *(u32x2*)(G + o + 16 * n) = pk4(acc[ai][1][m][n]); }
            }
    }
};

struct EpiFourier {
    bf16_t* mb;
    DI void operator()(AccRef acc, const pg8::Unit& u, int wr, int wc, int fr, int fq) const {
#pragma unroll
        for (int ai = 0; ai < 2; ++ai)
#pragma unroll
            for (int m = 0; m < 4; ++m) {
                const int row = u.pm * 256 + ai * 128 + wr * 64 + m * 16 + fr;
                bf16_t* mr = mb + (size_t)row * DM + wc * 32 + 4 * fq;
#pragma unroll
                for (int bj = 0; bj < 2; ++bj)
#pragma unroll
                    for (int n = 0; n < 2; ++n) *(u32x2*)(mr + bj * 128 + n * 16) = pk4(acc[ai][bj][m][n]);
            }
    }
};

template <class F>
DI void tr_tile(const int tid, LAS float* t, const float* src, int ld, bf16_t* dst, int Kd, int k0, int n0, F srccol) {
    { const int nn = tid & 63, kk = tid >> 6; const int sc = srccol(n0 + nn);
#pragma unroll
      for (int i = 0; i < 8; ++i) { const int k = kk + 8 * i; t[k * 65 + nn] = src[(size_t)(k0 + k) * ld + sc]; } }
    __syncthreads();
    { const int kp = tid & 31, nr = tid >> 5;
#pragma unroll
      for (int i = 0; i < 4; ++i) { const int n = nr + 16 * i; const float a = t[(2 * kp) * 65 + n], b = t[(2 * kp + 1) * 65 + n];
          *(unsigned*)(dst + (size_t)(n0 + n) * Kd + k0 + 2 * kp) = pk(a, b); } }
    __syncthreads();
}

DI void convert_weights(const Params& p, const Ctx X, int l, LAS unsigned char* lds) {
    LAS float* t = (LAS float*)lds;
    const int G = X.G, c = X.c, tid = X.tid;
    const bool even = (l & 1) == 0; const int eo = l >> 1;
    bf16_t* WIN = (bf16_t*)(p.ws + OFF_WIN); bf16_t* WOUT = (bf16_t*)(p.ws + OFF_WOUT); bf16_t* WUP = (bf16_t*)(p.ws + OFF_WUP); bf16_t* WDN = (bf16_t*)(p.ws + OFF_WDN);
    const float* w_out = p.in[16] + (size_t)l * 1024 * 1024;
    const float* w_up = p.in[17] + (size_t)l * 1024 * 5632;
    const float* w_dn = p.in[20] + (size_t)l * 2816 * 1024;
    const int n_in = even ? 20 * 16 : 36 * 16;
    const int n_out = even ? 16 * 8 : 16 * 16;
    const int n_up = 88 * 16, n_dn = 16 * 44;
    const int total = n_in + n_out + n_up + n_dn;
    for (int j = c; j < total; j += G) {
        int q = j;
        if (q < n_in) {
            const int nt_ = q >> 4, kt = q & 15;
            if (even) tr_tile(tid, t, p.in[8] + (size_t)eo * 1024 * 1280, 1280, WIN, 1024, kt * 64, nt_ * 64,
                              [](int n) { return n < 768 ? ((n & ~255) + ((n >> 5) & 3) * 64 + ((n >> 7) & 1) * 32 + (n & 31)) : n; });
            else tr_tile(tid, t, p.in[13] + (size_t)eo * 1024 * 2560, 2560, WIN, 1024, kt * 64, nt_ * 64,
                         [](int n) { return n < 1536 ? ((((n >> 7) & 1) ? 1536 : 0) + (n >> 8) * 128 + (n & 127)) : (768 + (n - 1536)); });
            continue;
        }
        q -= n_in;
        if (q < n_out) { const int nt_ = even ? (q >> 3) : (q >> 4), kt = even ? (q & 7) : (q & 15);
            tr_tile(tid, t, w_out, 1024, WOUT, 1024, kt * 64, nt_ * 64, [](int n) { return n; }); continue; }
        q -= n_out;
        if (q < n_up) { const int nt_ = q >> 4, kt = q & 15;
            tr_tile(tid, t, w_up, 5632, WUP, 1024, kt * 64, nt_ * 64, [](int n) { return (((n >> 7) & 1) ? 2816 : 0) + (n >> 8) * 128 + (n & 127); }); continue; }
        q -= n_up;
        { const int nt_ = q / 44, kt = q % 44; tr_tile(tid, t, w_dn, 1024, WDN, 2816, kt * 64, nt_ * 64, [](int n) { return n; }); }
    }
    if (even) {
        const float* wp = p.in[11] + (size_t)eo * 4 * 128 * 128; const float* sc = p.in[12] + (size_t)eo * 512;
        for (int uu = c; uu < 256; uu += G) {
            const int g = uu >> 6, c0 = (uu & 63) * 2;
            __syncthreads();
            if (tid < 256) { const int cc = tid >> 7, d = tid & 127; t[tid] = wp[((size_t)g * 128 + c0 + cc) * 128 + d] * sc[g * 128 + d]; }
            __syncthreads();
            float a00 = 0.f, a01 = 0.f, a10 = 0.f, a11 = 0.f;
            const float* wo = w_out + (size_t)(512 + g * 128) * 1024;
            for (int d = 0; d < 128; ++d) {
                const float w0 = wo[(size_t)d * 1024 + tid], w1 = wo[(size_t)d * 1024 + 512 + tid];
                const float k0 = t[d], k1 = t[128 + d];
                a00 += k0 * w0; a01 += k1 * w0; a10 += k0 * w1; a11 += k1 * w1;
            }
            *(unsigned*)(WOUT + (size_t)tid * 1024 + 512 + g * 128 + c0) = pk(a00, a01);
            *(unsigned*)(WOUT + (size_t)(tid + 512) * 1024 + 512 + g * 128 + c0) = pk(a10, a11);
        }
    } else {
        const float* wf = p.in[13] + (size_t)eo * 1024 * 2560 + 2304;
        __syncthreads();
        if (tid < 64) { float s, co; sincospif((float)tid * (1.0f / 32.0f), &s, &co); t[512 + tid] = co; t[576 + tid] = s; }
        for (int uu = c; uu < 512; uu += G) {
            __syncthreads();
            t[tid] = wf[(size_t)(2 * uu + (tid >> 8)) * 2560 + (tid & 255)];
            __syncthreads();
            const int part = tid >> 8, ch = tid & 255, g = ch >> 6, mm = ch & 63;
            float a0 = 0.f, a1 = 0.f;
            for (int cc = 0; cc < 64; ++cc) { const float tw = t[512 + part * 64 + ((mm * cc) & 63)]; a0 += tw * t[g * 64 + cc]; a1 += tw * t[256 + g * 64 + cc]; }
            *(unsigned*)(WIN + (size_t)(2304 + tid) * 1024 + 2 * uu) = pk(a0, a1);
        }
        __syncthreads();
    }
}

DI void prep_a(const Params& p, const Ctx X, LAS unsigned char* lds) {
    const int G = X.G, c = X.c, tid = X.tid, wid = tid >> 6, lane = tid & 63;
    {
        LAS float* sc = (LAS float*)lds;
        LAS float* part = sc + 9 * 1024;
        for (int i = tid; i < 9 * 1024; i += 512) { const int j = i >> 10, k = i & 1023; const float x = j == 0 ? p.in[5][k] : p.in[4][(size_t)(j - 1) * 1024 + k]; sc[i] = x / (1.0f + __expf(-x)); }
        __syncthreads();
        float* ada = (float*)(p.ws + OFF_ADA);
        for (int uu = c; uu < 384; uu += G) {
            const int l = uu / 96, cb = uu % 96;
            const float* w = p.in[6] + (size_t)l * 1024 * 6144 + cb * 64 + lane;
            float a[9];
#pragma unroll
            for (int j = 0; j < 9; ++j) a[j] = 0.f;
            const int k0 = wid * 128;
#pragma unroll 4
            for (int k = 0; k < 128; ++k) { const float wv = w[(size_t)(k0 + k) * 6144];
#pragma unroll
                for (int j = 0; j < 9; ++j) a[j] += sc[j * 1024 + k0 + k] * wv; }
#pragma unroll
            for (int j = 0; j < 9; ++j) part[(wid * 9 + j) * 64 + lane] = a[j];
            __syncthreads();
            for (int i = tid; i < 576; i += 512) { const int j = i >> 6, cc = i & 63; float s = 0.f;
#pragma unroll
                for (int w8 = 0; w8 < 8; ++w8) s += part[(w8 * 9 + j) * 64 + cc];
                ada[((size_t)l * 9 + j) * 6144 + cb * 64 + cc] = s + p.in[7][(size_t)l * 6144 + cb * 64 + cc]; }
            __syncthreads();
        }
    }
    convert_weights(p, X, 0, lds);
    const int gt = c * 512 + tid, GT = G * 512;
    {
        bf16_t* D = (bf16_t*)(p.ws + OFF_DFT);
        const float s = 1.0f / 362.03867196751236f;
        for (int i = gt; i < 2048 * 1024; i += GT) { const int k = i >> 10, t2 = (i & 1023) * 2;
            float s0, c0, s1, c1; sincospif((float)((k * t2) & 2047) * (1.0f / 1024.0f), &s0, &c0); sincospif((float)((k * (t2 + 1)) & 2047) * (1.0f / 1024.0f), &s1, &c1);
            *(unsigned*)(D + (size_t)k * 4096 + t2) = pk(c0 * s, c1 * s); *(unsigned*)(D + (size_t)k * 4096 + 2048 + t2) = pk(-s0 * s, -s1 * s); }
        bf16_t* D2 = (bf16_t*)(p.ws + OFF_DFT256);
        const float s2 = 1.0f / 128.0f;
        for (int i = gt; i < 256 * 128; i += GT) { const int k = i >> 7, t2 = (i & 127) * 2;
            float s0, c0, s1, c1; sincospif((float)((k * t2) & 255) * (1.0f / 128.0f), &s0, &c0); sincospif((float)((k * (t2 + 1)) & 255) * (1.0f / 128.0f), &s1, &c1);
            *(unsigned*)(D2 + (size_t)k * 512 + t2) = pk(c0 * s2, c1 * s2); *(unsigned*)(D2 + (size_t)k * 512 + 256 + t2) = pk(-s0 * s2, -s1 * s2); }
    }
    {
        float* R = (float*)(p.ws + OFF_ROPE);
        for (int i = gt; i < 2048 * 32; i += GT) { const int t = i >> 5, f = i & 31; const float pos = (float)(f < 16 ? (t >> 6) : (t & 63));
            const float inv = 1.0f / powf(10000.0f, (float)(f & 15) * (1.0f / 16.0f)); const float ang = pos * inv; R[2 * i] = cosf(ang); R[2 * i + 1] = sinf(ang); }
    }
    {
        for (int i = gt; i < 8 * 2 * 256 * 128; i += GT) {
            const int col = i & 127, s = (i >> 7) & 255, e = (i >> 15) & 1, b = i >> 16;
            bf16_t* Kl = (bf16_t*)(p.ws + OFF_KVL + (size_t)e * KVL_SZ); bf16_t* VTl = (bf16_t*)(p.ws + OFF_KVL + (size_t)(2 + e) * KVL_SZ);
            const unsigned kv = pk(p.in[2][i], 0.f), vv = pk(p.in[3][i], 0.f);
            Kl[((size_t)b * 2304 + 2048 + s) * 128 + col] = (bf16_t)(kv & 0xffff);
            const int h = col >> 6, d = col & 63;
            VTl[((size_t)(b * 2 + h) * 64 + d) * 2304 + 2048 + s] = (bf16_t)(vv & 0xffff);
        }
    }
}

template <int MODE>
DI void ln_pass(const Ctx X, const float* srcc, const float* srcl, float* xdst, bf16_t* udst, const float* lng, const float* lnb, const float* adash, const float* adasc) {
    const int lane = X.tid & 63, gw = X.c * 8 + (X.tid >> 6), GW = X.G * 8;
    for (int row = gw; row < T; row += GW) {
        const float* src = row < TC ? srcc + (size_t)row * DM : srcl + (size_t)(row - TC) * DM;
        f32x4 v[4];
#pragma unroll
        for (int i = 0; i < 4; ++i) v[i] = *(const f32x4*)(src + lane * 4 + 256 * i);
        if (MODE != 0) {
            float s = 0.f;
#pragma unroll
            for (int i = 0; i < 4; ++i) s += v[i][0] + v[i][1] + v[i][2] + v[i][3];
            const float mu = wsum(s) * (1.0f / 1024.0f);
            float q = 0.f;
#pragma unroll
            for (int i = 0; i < 4; ++i) { v[i] = v[i] - mu; q += v[i][0] * v[i][0] + v[i][1] * v[i][1] + v[i][2] * v[i][2] + v[i][3] * v[i][3]; }
            const float rstd = rsqrtf(wsum(q) * (1.0f / 1024.0f) + LN_EPS);
#pragma unroll
            for (int i = 0; i < 4; ++i) { const f32x4 g4 = *(const f32x4*)(lng + lane * 4 + 256 * i), b4 = *(const f32x4*)(lnb + lane * 4 + 256 * i);
                v[i] = v[i] * rstd * g4 + b4; *(f32x4*)(xdst + (size_t)row * DM + lane * 4 + 256 * i) = v[i]; }
        }
        if (MODE != 2) {
            float s = 0.f;
#pragma unroll
            for (int i = 0; i < 4; ++i) s += v[i][0] + v[i][1] + v[i][2] + v[i][3];
            const float mu = wsum(s) * (1.0f / 1024.0f);
            float q = 0.f;
#pragma unroll
            for (int i = 0; i < 4; ++i) { v[i] = v[i] - mu; q += v[i][0] * v[i][0] + v[i][1] * v[i][1] + v[i][2] * v[i][2] + v[i][3] * v[i][3]; }
            const float rstd = rsqrtf(wsum(q) * (1.0f / 1024.0f) + LN_EPS);
            const int cd = cond_of(row);
#pragma unroll
            for (int i = 0; i < 4; ++i) { const f32x4 s4 = *(const f32x4*)(adasc + cd * 6144 + lane * 4 + 256 * i), h4 = *(const f32x4*)(adash + cd * 6144 + lane * 4 + 256 * i);
                const f32x4 o = v[i] * rstd * (1.0f + s4) + h4; *(u32x2*)(udst + (size_t)row * DM + lane * 4 + 256 * i) = pk4(o); }
        }
    }
}

constexpr int KROW = 144, VROW = 136, KBUF = 64 * KROW, VBUF = 64 * VROW, ABUF = KBUF + VBUF;
DI void attn_unit(const int tid, LAS unsigned char* lds, const bf16_t* Q, const bf16_t* Kb, const bf16_t* VTb, int Lk, bf16_t* Mo, int q0row, int kvh) {
    const int wid = tid >> 6, lane = tid & 63, r = lane & 31, h = lane >> 5;
    const int head = kvh * 4 + (wid & 3);
    const int qrow = q0row + (wid >> 2) * 32 + r;
    bf16x8 qf[4];
#pragma unroll
    for (int ks = 0; ks < 4; ++ks) qf[ks] = *(const bf16x8*)(Q + (size_t)qrow * 512 + head * 64 + 16 * ks + 8 * h);
    const int srow = tid >> 3, sch = tid & 7;
    const bf16_t* kg = Kb + (size_t)srow * 128 + sch * 8;
    const bf16_t* vg = VTb + (size_t)srow * Lk + sch * 8;
    const int nt = Lk >> 6;
    u32x4 kreg = *(const u32x4*)kg, vreg = *(const u32x4*)vg;
    __syncthreads();
    *(LAS u32x4*)(lds + srow * KROW + sch * 16) = kreg;
    *(LAS u32x2*)(lds + KBUF + srow * VROW + sch * 16) = (u32x2){vreg.x, vreg.y};
    *(LAS u32x2*)(lds + KBUF + srow * VROW + sch * 16 + 8) = (u32x2){vreg.z, vreg.w};
    __syncthreads();
    f32x16 o[2];
#pragma unroll
    for (int i = 0; i < 16; ++i) { o[0][i] = 0.f; o[1][i] = 0.f; }
    float mrun = -1e30f, lsum = 0.f;
    for (int t = 0; t < nt; ++t) {
        LAS unsigned char* kb_ = lds + (t & 1) * ABUF; LAS unsigned char* vb_ = kb_ + KBUF;
        if (t + 1 < nt) { kreg = *(const u32x4*)(kg + (size_t)(t + 1) * 64 * 128); vreg = *(const u32x4*)(vg + (t + 1) * 64); }
        f32x16 s[2];
#pragma unroll
        for (int kb = 0; kb < 2; ++kb) {
#pragma unroll
            for (int i = 0; i < 16; ++i) s[kb][i] = 0.f;
#pragma unroll
            for (int ks = 0; ks < 4; ++ks) {
                const bf16x8 kf = *(const LAS bf16x8*)(kb_ + (kb * 32 + r) * KROW + (16 * ks + 8 * h) * 2);
                s[kb] = __builtin_amdgcn_mfma_f32_32x32x16_bf16(kf, qf[ks], s[kb], 0, 0, 0);
            }
        }
        __builtin_amdgcn_sched_barrier(0);
        float mx = s[0][0];
#pragma unroll
        for (int i = 1; i < 16; ++i) mx = fmaxf(mx, s[0][i]);
#pragma unroll
        for (int i = 0; i < 16; ++i) mx = fmaxf(mx, s[1][i]);
        mx = fmaxf(mx, __shfl_xor(mx, 32));
        const float mnew = fmaxf(mrun, mx);
        const float al = __builtin_amdgcn_exp2f(mrun - mnew);
        mrun = mnew;
        float ps = 0.f;
#pragma unroll
        for (int kb = 0; kb < 2; ++kb)
#pragma unroll
            for (int i = 0; i < 16; ++i) { s[kb][i] = __builtin_amdgcn_exp2f(s[kb][i] - mnew); ps += s[kb][i]; }
        lsum = lsum * al + ps;
#pragma unroll
        for (int i = 0; i < 16; ++i) { o[0][i] *= al; o[1][i] *= al; }
#pragma unroll
        for (int kb = 0; kb < 2; ++kb)
#pragma unroll
            for (int st = 0; st < 2; ++st) {
                u32x4 pp;
                pp.x = pk(s[kb][8 * st + 0], s[kb][8 * st + 1]); pp.y = pk(s[kb][8 * st + 2], s[kb][8 * st + 3]);
                pp.z = pk(s[kb][8 * st + 4], s[kb][8 * st + 5]); pp.w = pk(s[kb][8 * st + 6], s[kb][8 * st + 7]);
                const bf16x8 pf = __builtin_bit_cast(bf16x8, pp);
#pragma unroll
                for (int db = 0; db < 2; ++db) {
                    const LAS unsigned char* va = vb_ + (db * 32 + r) * VROW + (kb * 32 + 16 * st + 4 * h) * 2;
                    const u32x2 v0 = *(const LAS u32x2*)va, v1 = *(const LAS u32x2*)(va + 16);
                    const u32x4 vv = {v0.x, v0.y, v1.x, v1.y};
                    o[db] = __builtin_amdgcn_mfma_f32_32x32x16_bf16(__builtin_bit_cast(bf16x8, vv), pf, o[db], 0, 0, 0);
                }
                __builtin_amdgcn_sched_barrier(0);
            }
        if (t + 1 < nt) {
            LAS unsigned char* nb = lds + ((t + 1) & 1) * ABUF;
            *(LAS u32x4*)(nb + srow * KROW + sch * 16) = kreg;
            *(LAS u32x2*)(nb + KBUF + srow * VROW + sch * 16) = (u32x2){vreg.x, vreg.y};
            *(LAS u32x2*)(nb + KBUF + srow * VROW + sch * 16 + 8) = (u32x2){vreg.z, vreg.w};
        }
        __syncthreads();
    }
    const float lt = lsum + __shfl_xor(lsum, 32);
    const float inv = 1.0f / lt;
    bf16_t* mo = Mo + (size_t)qrow * DM + head * 64 + 4 * h;
#pragma unroll
    for (int db = 0; db < 2; ++db)
#pragma unroll
        for (int g = 0; g < 4; ++g) {
            const f32x4 ov = {o[db][4 * g] * inv, o[db][4 * g + 1] * inv, o[db][4 * g + 2] * inv, o[db][4 * g + 3] * inv};
            *(u32x2*)(mo + db * 32 + g * 8) = pk4(ov);
        }
}

DI void mixer_even(const Params& p, const Ctx X, int e, LAS unsigned char* lds) {
    const int G = X.G, c = X.c, tid = X.tid;
    const bf16_t* Q = (const bf16_t*)(p.ws + OFF_Q); const bf16_t* P = (const bf16_t*)(p.ws + OFF_P);
    const bf16_t* Kc = (const bf16_t*)(p.ws + OFF_KC); const bf16_t* VTc = (const bf16_t*)(p.ws + OFF_VTC);
    const bf16_t* Kl = (const bf16_t*)(p.ws + OFF_KVL + (size_t)e * KVL_SZ); const bf16_t* VTl = (const bf16_t*)(p.ws + OFF_KVL + (size_t)(2 + e) * KVL_SZ);
    bf16_t* Mo = (bf16_t*)(p.ws + OFF_R1);
    for (int u = c; u < 512; u += G) {
        const int b = u >> 6, kvh = (u >> 5) & 1, qb = u & 31;
        attn_unit(tid, lds, Q, Kl + (size_t)b * 2304 * 128 + kvh * 64, VTl + (size_t)(b * 2 + kvh) * 64 * 2304, 2304, Mo, TC + b * 2048 + qb * 64, kvh);
    }
    for (int u = c; u < 128; u += G) {
        const int bb = u >> 3, kvh = (u >> 2) & 1, qb = u & 3;
        attn_unit(tid, lds, Q, Kc + (size_t)bb * 256 * 128 + kvh * 64, VTc + (size_t)(bb * 2 + kvh) * 64 * 256, 256, Mo, bb * 256 + qb * 64, kvh);
    }
    for (int u = G - 1 - c; u < 320; u += G) {
        const int row0 = u * 64;
        const int seq0 = row0 < TC ? (row0 & ~255) : TC + ((row0 - TC) & ~2047);
        const int L = row0 < TC ? 256 : 2048;
        const int cp = tid & 255, th = tid >> 8, half = 1 << (cp >> 6);
        for (int i = 0; i < 32; ++i) {
            const int row = row0 + th * 32 + i, tl = row - seq0;
            const int lo = max(tl - half, 0), hi = min(tl + half, L);
            float s0 = 0.f, s1 = 0.f;
            for (int j = lo; j < hi; ++j) { const unsigned v = *(const unsigned*)(P + (size_t)(seq0 + j) * 512 + 2 * cp); s0 += bflo(v); s1 += bfhi(v); }
            const unsigned sv = *(const unsigned*)(P + (size_t)row * 512 + 2 * cp);
            const float ic = 1.0f / (float)(hi - lo);
            *(unsigned*)(Mo + (size_t)row * DM + 512 + 2 * cp) = pk(s0 * ic - bflo(sv), s1 * ic - bfhi(sv));
        }
    }
}

DI void mixer_odd(const Params& p, const Ctx X, int o, LAS unsigned char* lds) {
    const int G = X.G, c = X.c, tid = X.tid;
    bf16_t* Mo = (bf16_t*)(p.ws + OFF_R1);
    for (int u = c; u < 80; u += G) {
        pg8::Gemm g; pg8::OneUnit S; EpiFourier E;
        if (u < 64) { const int b = u >> 3, pm = u & 7;
            g = pg8::Gemm{(const bf16_t*)(p.ws + OFF_DFT), (const bf16_t*)(p.ws + OFF_XTL) + (size_t)b * 256 * 4096, 2048, 256, 4096};
            S = pg8::OneUnit{pm, 0, 1}; E.mb = Mo + (size_t)(TC + b * 2048) * DM + 768; }
        else { const int bb = u - 64;
            g = pg8::Gemm{(const bf16_t*)(p.ws + OFF_DFT256), (const bf16_t*)(p.ws + OFF_XTC) + (size_t)bb * 256 * 512, 256, 256, 512};
            S = pg8::OneUnit{0, 0, 1}; E.mb = Mo + (size_t)(bb * 256) * DM + 768; }
        pg8::gemm_phase<EpiFourier, pg8::OneUnit>(lds, g, S, E, tid);
    }
    const bf16_t* HC = (const bf16_t*)(p.ws + OFF_HC); const bf16_t* BG = (const bf16_t*)(p.ws + OFF_BG);
    const float* cw = p.in[14] + (size_t)o * 3 * 768; const float* cb = p.in[15] + (size_t)o * 768;
    const int first = G >= 160 ? 80 : 0, nW = G - first;
    if (c >= first) {
        for (int i = (c - first) * 512 + tid; i < T * 192; i += nW * 512) {
            const int row = i / 192, q4 = (i % 192) * 4;
            const int L = row < TC ? 256 : 2048, tl = row < TC ? (row & 255) : ((row - TC) & 2047);
            const f32x4 w0 = *(const f32x4*)(cw + q4), w1 = *(const f32x4*)(cw + 768 + q4), w2 = *(const f32x4*)(cw + 1536 + q4), bb = *(const f32x4*)(cb + q4);
            const bf16_t* hp = HC + (size_t)row * 768 + q4;
            f32x4 z = bb + w1 * up4(*(const u32x2*)hp);
            if (tl > 0) z += w0 * up4(*(const u32x2*)(hp - 768));
            if (tl < L - 1) z += w2 * up4(*(const u32x2*)(hp + 768));
            const f32x4 bg = up4(*(const u32x2*)(BG + (size_t)row * 768 + q4));
            *(u32x2*)(Mo + (size_t)row * DM + q4) = pk4(bg * z);
        }
    }
}

DI void ffn_conv(const Params& p, const Ctx X, int l, int chunk) {
    bf16_t* A = (bf16_t*)(p.ws + OFF_R1); bf16_t* Gb = (bf16_t*)(p.ws + OFF_GB);
    const float* cw = p.in[18] + (size_t)l * 3 * DFF; const float* cb = p.in[19] + (size_t)l * DFF;
    const int G = X.G;
    for (int i = X.c * 512 + X.tid; i < CH * 704; i += G * 512) {
        const int rl = i / 704, q4 = (i % 704) * 4, row = chunk * CH + rl;
        const int L = row < TC ? 256 : 2048, tl = row < TC ? (row & 255) : ((row - TC) & 2047);
        const f32x4 w0 = *(const f32x4*)(cw + q4), w1 = *(const f32x4*)(cw + DFF + q4), w2 = *(const f32x4*)(cw + 2 * DFF + q4), bb = *(const f32x4*)(cb + q4);
        const bf16_t* ap = A + (size_t)rl * DFF + q4;
        f32x4 z = bb + w1 * up4(*(const u32x2*)ap);
        if (tl > 0) z += w0 * up4(*(const u32x2*)(ap - DFF));
        if (tl < L - 1) z += w2 * up4(*(const u32x2*)(ap + DFF));
        bf16_t* gp = Gb + (size_t)rl * DFF + q4;
        const f32x4 gv = up4(*(const u32x2*)gp);
        f32x4 y;
#pragma unroll
        for (int j = 0; j < 4; ++j) y[j] = z[j] * __builtin_amdgcn_rcpf(1.0f + __builtin_amdgcn_exp2f(-1.4426950408889634f * z[j])) * gv[j];
        *(u32x2*)gp = pk4(y);
    }
}

__global__ void __launch_bounds__(512, 2) mk_fwd(Params p_) {
    extern __shared__ __attribute__((aligned(16))) unsigned char lds_raw[];
    cg::grid_group grid = cg::this_grid();
    const int ph_lo = p_.ph_lo, ph_hi = p_.ph_hi;
    for (int ph = ph_lo; ph < ph_hi; ++ph) {
        Ctx X; X.tid = threadIdx.x; X.c = blockIdx.x; X.G = gridDim.x;
        asm volatile("" : "+v"(X.tid)); asm volatile("" : "+s"(X.c)); asm volatile("" : "+s"(X.G));
#if defined(__HIP_DEVICE_COMPILE__)
        const __attribute__((address_space(4))) Params* pp = (const __attribute__((address_space(4))) Params*)__builtin_amdgcn_kernarg_segment_ptr();
        asm volatile("" : "+s"(pp));
        const Params p = *pp;
#else
        const Params p = p_;
#endif
        unsigned lds_u = 0; asm volatile("" : "+s"(lds_u));
        LAS unsigned char* lds = (LAS unsigned char*)lds_raw + lds_u;
        const int G = X.G, c = X.c, tid = X.tid;
        float* XB = (float*)(p.ws + OFF_XB);
        bf16_t* UM = (bf16_t*)(p.ws + OFF_R1);
        bf16_t* U2 = (bf16_t*)(p.ws + OFF_R2);
        const float* ada = (const float*)(p.ws + OFF_ADA);
        if (EN(0) && ph == 0) prep_a(p, X, lds);
        else if (EN(1) && ph == 1) ln_pass<0>(X, p.in[0], p.in[1], nullptr, UM, nullptr, nullptr, ada + 0, ada + 1024);
        else {
            const int l = (ph - 2) / 11, sub = (ph - 2) % 11;
            const bool even = (l & 1) == 0; const int eo = l >> 1;
            const float* adal = ada + (size_t)l * 9 * 6144;
            if (sub == 0) {
                if (EN(2) && even) {
                    pg8::Gemm g{UM, (const bf16_t*)(p.ws + OFF_WIN), T, 1280, 1024}; pg8::StaticOrder S; S.init(T, 1280, G, c);
                    EpiEvenIn E{(bf16_t*)(p.ws + OFF_Q), (bf16_t*)(p.ws + OFF_P), (bf16_t*)(p.ws + OFF_KC), (bf16_t*)(p.ws + OFF_VTC),
                                (bf16_t*)(p.ws + OFF_KVL + (size_t)eo * KVL_SZ), (bf16_t*)(p.ws + OFF_KVL + (size_t)(2 + eo) * KVL_SZ),
                                p.out + 20971520, p.out + 22020096, p.in[9] + eo * 64, p.in[10] + eo * 64, (const float*)(p.ws + OFF_ROPE), eo};
                    pg8::gemm_phase<EpiEvenIn, pg8::StaticOrder>(lds, g, S, E, tid);
                } else if (EN(3)) {
                    pg8::Gemm g{UM, (const bf16_t*)(p.ws + OFF_WIN), T, 2816, 1024}; pg8::StaticOrder S; S.init(T, 2816, G, c);
                    EpiOddIn E{(bf16_t*)(p.ws + OFF_HC), (bf16_t*)(p.ws + OFF_BG), (bf16_t*)(p.ws + OFF_XTC), (bf16_t*)(p.ws + OFF_XTL)};
                    pg8::gemm_phase<EpiOddIn, pg8::StaticOrder>(lds, g, S, E, tid);
                }
            } else if (sub == 1) {
                if (EN(4) && even) mixer_even(p, X, eo, lds); else if (EN(5) && !even) mixer_odd(p, X, eo, lds);
            } else if (EN(6) && sub == 2) {
                pg8::Gemm g{UM, (const bf16_t*)(p.ws + OFF_WOUT), T, 1024, 1024}; pg8::StaticOrder S; S.init(T, 1024, G, c);
                EpiRes E{l == 0 ? p.in[0] : XB, l == 0 ? p.in[1] : XB + (size_t)TC * DM, XB, adal + 2048, 0};
                pg8::gemm_phase<EpiRes, pg8::StaticOrder>(lds, g, S, E, tid);
            } else if (EN(7) && sub == 3) {
                ln_pass<1>(X, XB, XB + (size_t)TC * DM, XB, U2, p.in[21] + (size_t)(l * 2) * 1024, p.in[22] + (size_t)(l * 2) * 1024, adal + 3072, adal + 4096);
            } else if (EN(8) && (sub == 4 || sub == 7)) {
                const int ch = sub == 7;
                pg8::Gemm g{U2 + (size_t)ch * CH * DM, (const bf16_t*)(p.ws + OFF_WUP), CH, 5632, 1024}; pg8::StaticOrder S; S.init(CH, 5632, G, c);
                EpiUp E{(bf16_t*)(p.ws + OFF_R1), (bf16_t*)(p.ws + OFF_GB)};
                pg8::gemm_phase<EpiUp, pg8::StaticOrder>(lds, g, S, E, tid);
            } else if (EN(9) && (sub == 5 || sub == 8)) {
                ffn_conv(p, X, l, sub == 8);
            } else if (EN(10) && (sub == 6 || sub == 9)) {
                const int ch = sub == 9;
                pg8::Gemm g{(const bf16_t*)(p.ws + OFF_GB), (const bf16_t*)(p.ws + OFF_WDN), CH, 1024, 2816}; pg8::StaticOrder S; S.init(CH, 1024, G, c);
                EpiRes E{XB, XB + (size_t)TC * DM, XB, adal + 5120, ch * CH};
                pg8::gemm_phase<EpiRes, pg8::StaticOrder>(lds, g, S, E, tid);
            } else if (EN(11)) {
                const float* lg = p.in[21] + (size_t)(l * 2 + 1) * 1024; const float* lb = p.in[22] + (size_t)(l * 2 + 1) * 1024;
                if (l == 3) ln_pass<2>(X, XB, XB + (size_t)TC * DM, p.out, nullptr, lg, lb, nullptr, nullptr);
                else { ln_pass<1>(X, XB, XB + (size_t)TC * DM, XB, UM, lg, lb, adal + 9 * 6144 + 0, adal + 9 * 6144 + 1024); convert_weights(p, X, l + 1, lds); }
            }
        }
        if (ph + 1 < ph_hi) grid.sync();
    }
}

extern "C" void kernel_launch(void* const* d_in, const int* in_sizes, int n_in, void* d_out, int out_size, void* d_ws, size_t ws_size, hipStream_t stream) {
    static int grid = 0;
    if (grid == 0) {
        int dev = 0, cus = 0, per_cu = 0;
        (void)hipGetDevice(&dev);
        (void)hipDeviceGetAttribute(&cus, hipDeviceAttributeMultiprocessorCount, dev);
        (void)hipFuncSetAttribute((const void*)mk_fwd, hipFuncAttributeMaxDynamicSharedMemorySize, LDS_BYTES);
        (void)hipOccupancyMaxActiveBlocksPerMultiprocessor(&per_cu, (const void*)mk_fwd, 512, LDS_BYTES);
        if (per_cu < 1) { fprintf(stderr, "kernel_launch: occupancy query reports %d blocks per CU\n", per_cu); per_cu = 1; }
        (void)hipGetLastError();
        grid = cus;
        if (n_in != 23 || ws_size < WS_END) { fprintf(stderr, "kernel_launch: n_in %d ws %zu (need %zu)\n", n_in, ws_size, (size_t)WS_END); }
    }
    Params p{};
    for (int i = 0; i < 23; ++i) p.in[i] = (const float*)d_in[i];
    p.out = (float*)d_out; p.ws = (unsigned char*)d_ws;
#if MULTI_LAUNCH
    for (int ph = 0; ph < NPH; ++ph) { p.ph_lo = ph; p.ph_hi = ph + 1; hipLaunchKernelGGL(mk_fwd, dim3(grid), dim3(512), LDS_BYTES, stream, p); }
#else
    p.ph_lo = 0; p.ph_hi = NPH;
    void* args[] = {&p};
    hipError_t e = hipLaunchCooperativeKernel((const void*)mk_fwd, dim3(grid), dim3(512), args, LDS_BYTES, stream);
    if (e != hipSuccess) fprintf(stderr, "cooperative launch failed: %s (grid %d)\n", hipGetErrorString(e), grid);
#endif
}
```

```cpp
#include <hip/hip_runtime.h>
#include <hip/hip_cooperative_groups.h>
#include <cstdio>
namespace cg = cooperative_groups;

#ifndef PHMASK
#define PHMASK 0xffff
#endif
#define EN(b) ((PHMASK >> (b)) & 1)
#ifndef PROBE_CATS
#define PROBE_CATS 0
#endif
#ifndef MULTI_LAUNCH
#define MULTI_LAUNCH 0
#endif

#define DI __device__ __forceinline__
#define LAS __attribute__((address_space(3)))
typedef unsigned short bf16_t;
typedef short bf16x8 __attribute__((ext_vector_type(8)));
typedef float f32x4 __attribute__((ext_vector_type(4)));
typedef float f32x2 __attribute__((ext_vector_type(2)));
typedef float f32x16 __attribute__((ext_vector_type(16)));
typedef unsigned u32x4 __attribute__((ext_vector_type(4)));
typedef unsigned u32x2 __attribute__((ext_vector_type(2)));
typedef __bf16 bf2_t __attribute__((ext_vector_type(2)));

constexpr int T = 20480, TC = 4096, DM = 1024;
constexpr int DFF = 2816;
constexpr int CH = 10240;
constexpr float ALPHA = 1.6817928305074292f;
constexpr float LN_EPS = 1e-6f, RMS_EPS = 1e-6f;
constexpr float QSCALE = 0.125f * 1.4426950408889634f;
constexpr size_t MiB = 1048576;
constexpr size_t OFF_XB = 0;
constexpr size_t OFF_R1 = 80 * MiB;
constexpr size_t OFF_GB = OFF_R1 + 55 * MiB;
constexpr size_t OFF_R2 = 190 * MiB;
constexpr size_t OFF_Q = OFF_R2, OFF_P = OFF_R2 + 20 * MiB, OFF_KC = OFF_R2 + 40 * MiB, OFF_VTC = OFF_R2 + 41 * MiB;
constexpr size_t OFF_HC = OFF_R2, OFF_BG = OFF_R2 + 30 * MiB, OFF_XTC = OFF_R2 + 60 * MiB, OFF_XTL = OFF_R2 + 64 * MiB;
constexpr size_t OFF_W = 270 * MiB;
constexpr size_t OFF_WIN = OFF_W, OFF_WOUT = OFF_W + 11 * MiB / 2, OFF_WUP = OFF_W + 15 * MiB / 2, OFF_WDN = OFF_W + 37 * MiB / 2;
constexpr size_t OFF_DFT = 294 * MiB;
constexpr size_t OFF_DFT256 = OFF_DFT + 16 * MiB;
constexpr size_t OFF_KVL = 311 * MiB;
constexpr size_t KVL_SZ = (size_t)8 * 2304 * 128 * 2;
constexpr size_t OFF_ADA = 329 * MiB;
constexpr size_t OFF_ROPE = 330 * MiB;
constexpr size_t OFF_EDGE = 331 * MiB;
constexpr size_t OFF_STATS = 337 * MiB;
constexpr size_t OFF_W2 = 338 * MiB;
constexpr size_t OFF_BAR = 362 * MiB;
constexpr size_t WS_END = 363 * MiB;
constexpr int HALO_OFF = 131072;
constexpr int XBST_OFF = 131072 + 4096;
constexpr int LDS_BYTES = 131072 + 4096 + 16;
constexpr int NSUB = 7;
constexpr int NPH = 2 + 4 * NSUB;

struct Params { const float* in[23]; float* out; unsigned char* ws; int ph_lo, ph_hi; };
#if defined(__HIP_DEVICE_COMPILE__)
typedef const __attribute__((address_space(4))) Params* ParamsPtr;
#else
typedef const Params* ParamsPtr;
#endif
struct PRef {
    ParamsPtr q;
    DI const float* in(int k) const { return q->in[k]; }
    DI float* out() const { return q->out; }
    DI unsigned char* ws() const { return q->ws; }
};
struct Ctx { int tid, c, G; };

DI unsigned pk(float lo, float hi) { f32x2 v = {lo, hi}; return __builtin_bit_cast(unsigned, __builtin_convertvector(v, bf2_t)); }
DI float bflo(unsigned u) { return __uint_as_float(u << 16); }
DI float bfhi(unsigned u) { return __uint_as_float(u & 0xffff0000u); }
DI u32x2 pk4(f32x4 v) { u32x2 r; r.x = pk(v[0], v[1]); r.y = pk(v[2], v[3]); return r; }
DI f32x4 up4(u32x2 u) { f32x4 r = {bflo(u.x), bfhi(u.x), bflo(u.y), bfhi(u.y)}; return r; }
DI int cond_of(int row) { return row < TC ? 0 : 1 + ((row - TC) >> 11); }
DI float wsum(float v) {
#pragma unroll
    for (int o = 32; o > 0; o >>= 1) v += __shfl_xor(v, o);
    return v;
}

namespace pg8 {
constexpr int BM = 256, BK = 64, HALF = 128, HTB = HALF * BK * 2, STAGE_BYTES = 8 * HTB, NXCD = 8, WGM = 8;
DI int lds_byte(int r, int c) { const int st = (r >> 4) * 2 + (c >> 5), rr = r & 15, cc = c & 31, ob = rr * 64 + cc * 2; return st * 1024 + (ob ^ (((ob >> 9) & 1) << 5)); }
DI void stage_rc(int b, int& R, int& C) { const int st = b / 1024, sb = b % 1024, swz = sb ^ (((sb >> 9) & 1) << 5); R = (st >> 1) * 16 + swz / 64; C = (st & 1) * 32 + (swz % 64) / 2; }
struct Unit { int pm, pn, kt0, nt, role, slab; };
struct Gemm { const bf16_t* A; const bf16_t* Bt; int M, N, K, lda, ldb; };
struct StaticOrder {
    int nM, nN, nwg, G, c, nt0;
    DI void init(int M, int N, int G_, int c_, int K_ = 1024) { nM = M / BM; nN = N / BM; nwg = nM * nN; G = G_; c = c_; nt0 = K_ / BK; }
    DI bool unit_of(long L, Unit& u) const {
        if (L >= nwg) return false;
        u.kt0 = 0; u.nt = nt0; u.role = 0; u.slab = 0;
        int wgid = (int)L; { const int q = nwg / NXCD, r = nwg % NXCD, xcd = wgid % NXCD, off = wgid / NXCD; wgid = (xcd < r ? xcd * (q + 1) : r * (q + 1) + (xcd - r) * q) + off; }
        const int nig = WGM * nN, gid = wgid / nig, fm = gid * WGM, gsz = (nM - fm) < WGM ? (nM - fm) : WGM;
        u.pm = fm + ((wgid % nig) % gsz); u.pn = (wgid % nig) / gsz; return true;
    }
    DI bool next(int i, Unit& u) const { return unit_of((long)i * G + c, u); }
    DI void a_ready(const Unit&) const {}
    DI void done(const Unit&) const {}
};
struct SplitOrder : StaticOrder {
    DI bool next(int i, Unit& u) const {
        if (G != 256 || nwg != 320) return unit_of((long)i * G + c, u);
        if (i == 0) return unit_of(c, u);
        if (i != 1 || c >= 128) return false;
        unit_of(256 + (c & 63), u); const int h = c >> 6; u.nt = nt0 / 2; u.kt0 = h * (nt0 / 2); u.role = h ? 1 : 2; u.slab = c & 63; return true;
    }
};
struct OneUnit {
    int pm, pn, kt0, nt, role, slab;
    DI bool next(int i, Unit& u) const { if (i != 0) return false; u.pm = pm; u.pn = pn; u.kt0 = kt0; u.nt = nt; u.role = role; u.slab = slab; return true; }
    DI void a_ready(const Unit&) const {}
    DI void done(const Unit&) const {}
};

template <class Epi, class Sched>
DI void gemm_phase(LAS unsigned char* lds, const Gemm g, const Sched& S, const Epi& E, const int tid) {
    const int wid = __builtin_amdgcn_readfirstlane(tid >> 6), lane = tid & 63, wr = wid >> 2, wc = wid & 3, fr = lane & 15, fq = lane >> 4;
    unsigned voffA[2], voffB[2];
#pragma unroll
    for (int i = 0; i < 2; ++i) { int R, C; stage_rc(tid * 16 + i * 8192, R, C); voffA[i] = (unsigned)(R * g.lda + C) * 2u; voffB[i] = (unsigned)(R * g.ldb + C) * 2u; }
    const size_t kstep = (size_t)(BK * 2);
    const size_t hstepA = (size_t)HALF * g.lda * 2, hstepB = (size_t)HALF * g.ldb * 2;
    const size_t tstepA = 2 * hstepA, tstepB = 2 * hstepB;
    const unsigned ldsw = (unsigned)wid * 1024u;
    const int aoff = lds_byte(wr * 64 + fr, fq * 8), boff = lds_byte(wc * 32 + fr, fq * 8);
#define PG8_SA(b, h) (((b) * 2 + (h)) * HTB)
#define PG8_SB(b, h) ((4 + (b) * 2 + (h)) * HTB)
#define PG8_STAGE(bufoff, gbase, voff) do { _Pragma("unroll") for (int _i = 0; _i < 2; ++_i) \
        __builtin_amdgcn_global_load_lds((const unsigned*)((const char*)(gbase) + (voff)[_i]), (LAS unsigned*)(lds + (bufoff) + ldsw + _i * 8192), 16, 0, 0); } while (0)
#define PG8_LDA(dst, b, h) do { _Pragma("unroll") for (int m = 0; m < 4; ++m) _Pragma("unroll") for (int k = 0; k < 2; ++k) dst[m][k] = *(const LAS bf16x8*)(lds + PG8_SA(b, h) + aoff + m * 2048 + k * 1024); } while (0)
#define PG8_LDB(dst, b, h) do { _Pragma("unroll") for (int n = 0; n < 2; ++n) _Pragma("unroll") for (int k = 0; k < 2; ++k) dst[n][k] = *(const LAS bf16x8*)(lds + PG8_SB(b, h) + boff + n * 2048 + k * 1024); } while (0)
#define PG8_MMA(ai, bj, At, Bt) do { __builtin_amdgcn_s_setprio(1); _Pragma("unroll") for (int m = 0; m < 4; ++m) _Pragma("unroll") for (int n = 0; n < 2; ++n) _Pragma("unroll") for (int k = 0; k < 2; ++k) \
        acc[ai][bj][m][n] = __builtin_amdgcn_mfma_f32_16x16x32_bf16(Bt[n][k], At[m][k], acc[ai][bj][m][n], 0, 0, 0); __builtin_amdgcn_s_setprio(0); } while (0)
#define PG8_WAIT_V(n) asm volatile("s_waitcnt vmcnt(" #n ")" ::: "memory")
#define PG8_WAIT_L(n) asm volatile("s_waitcnt lgkmcnt(" #n ")" ::: "memory")
#define PG8_BAR __builtin_amdgcn_s_barrier()
#define PG8_SCHED __builtin_amdgcn_sched_barrier(0)
    Unit cur, nxt; int ui = 0;
    if (!S.next(0, cur)) return;
    f32x4 acc[2][2][4][2];
#pragma unroll
    for (int a = 0; a < 2; ++a)
#pragma unroll
        for (int b = 0; b < 2; ++b)
#pragma unroll
            for (int m = 0; m < 4; ++m)
#pragma unroll
                for (int n = 0; n < 2; ++n) acc[a][b][m][n] = (f32x4){0.f, 0.f, 0.f, 0.f};
    bf16x8 At[4][2], B0[2][2], B1[2][2];
    const char* cA = (const char*)g.A + (size_t)cur.pm * tstepA + (size_t)cur.kt0 * kstep; const char* cB = (const char*)g.Bt + (size_t)cur.pn * tstepB + (size_t)cur.kt0 * kstep;
    S.a_ready(cur);
    PG8_STAGE(PG8_SB(0, 0), cB, voffB); PG8_STAGE(PG8_SA(0, 0), cA, voffA); PG8_STAGE(PG8_SB(0, 1), cB + hstepB, voffB); PG8_STAGE(PG8_SA(0, 1), cA + hstepA, voffA);
    if (wr == 1) PG8_BAR;
    PG8_WAIT_V(4); PG8_BAR;
    PG8_STAGE(PG8_SB(1, 0), cB + kstep, voffB); PG8_STAGE(PG8_SA(1, 0), cA + kstep, voffA); PG8_STAGE(PG8_SB(1, 1), cB + hstepB + kstep, voffB);
    PG8_WAIT_V(6); PG8_BAR;
    for (;;) {
        const bool has_next = S.next(ui + 1, nxt);
        const char* nA = has_next ? (const char*)g.A + (size_t)nxt.pm * tstepA + (size_t)nxt.kt0 * kstep : cA; const char* nB = has_next ? (const char*)g.Bt + (size_t)nxt.pn * tstepB + (size_t)nxt.kt0 * kstep : cB;
        const int nt = cur.nt;
        for (int t = 0; t < nt; t += 2) {
            const bool last = (t == nt - 2);
            const char* a1 = cA + (size_t)(t + 1) * kstep;
            const char* a2 = last ? nA : cA + (size_t)(t + 2) * kstep; const char* b2 = last ? nB : cB + (size_t)(t + 2) * kstep;
            const char* a3 = a2 + kstep; const char* b3 = b2 + kstep;
            if (last && has_next) S.a_ready(nxt);
            PG8_LDB(B0, 0, 0); PG8_SCHED; PG8_LDA(At, 0, 0); PG8_STAGE(PG8_SA(1, 1), a1 + hstepA, voffA);
            PG8_WAIT_L(8); PG8_BAR; PG8_WAIT_L(0); PG8_MMA(0, 0, At, B0); PG8_BAR; PG8_SCHED;
            PG8_LDB(B1, 0, 1); PG8_STAGE(PG8_SB(0, 0), b2, voffB);
            PG8_BAR; PG8_WAIT_L(0); PG8_MMA(0, 1, At, B1); PG8_BAR;
            PG8_LDA(At, 0, 1); PG8_STAGE(PG8_SA(0, 0), a2, voffA);
            PG8_BAR; PG8_WAIT_L(0); PG8_MMA(1, 0, At, B0); PG8_BAR; PG8_SCHED;
            PG8_STAGE(PG8_SB(0, 1), b2 + hstepB, voffB);
            PG8_WAIT_V(6); PG8_BAR; PG8_MMA(1, 1, At, B1); PG8_BAR;
            PG8_LDB(B0, 1, 0); PG8_SCHED; PG8_LDA(At, 1, 0); PG8_STAGE(PG8_SA(0, 1), a2 + hstepA, voffA);
            PG8_WAIT_L(8); PG8_BAR; PG8_WAIT_L(0); PG8_MMA(0, 0, At, B0); PG8_BAR; PG8_SCHED;
            PG8_LDB(B1, 1, 1); PG8_STAGE(PG8_SB(1, 0), b3, voffB);
            PG8_BAR; PG8_WAIT_L(0); PG8_MMA(0, 1, At, B1); PG8_BAR;
            PG8_LDA(At, 1, 1); PG8_STAGE(PG8_SA(1, 0), a3, voffA);
            PG8_BAR; PG8_WAIT_L(0); PG8_MMA(1, 0, At, B0); PG8_BAR; PG8_SCHED;
            PG8_STAGE(PG8_SB(1, 1), b3 + hstepB, voffB);
            PG8_WAIT_V(6); PG8_BAR; PG8_MMA(1, 1, At, B1); PG8_BAR;
        }
        E(acc, cur, wr, wc, fr, fq); S.done(cur);
#if defined(PROBE_EPI2)
        if constexpr (Epi::IDEMP) E(acc, cur, wr, wc, fr, fq);
#endif
        if (!has_next) break;
#pragma unroll
        for (int a = 0; a < 2; ++a)
#pragma unroll
            for (int b = 0; b < 2; ++b)
#pragma unroll
                for (int m = 0; m < 4; ++m)
#pragma unroll
                    for (int n = 0; n < 2; ++n) acc[a][b][m][n] = (f32x4){0.f, 0.f, 0.f, 0.f};
        cur = nxt; cA = nA; cB = nB; ++ui;
    }
    PG8_WAIT_V(0);
    if (wr == 0) PG8_BAR;
    PG8_BAR;
#undef PG8_SA
#undef PG8_SB
#undef PG8_STAGE
#undef PG8_LDA
#undef PG8_LDB
#undef PG8_MMA
#undef PG8_WAIT_V
#undef PG8_WAIT_L
#undef PG8_BAR
#undef PG8_SCHED
}
}

typedef const f32x4 (&AccRef)[2][2][4][2];
DI int lpos(int n) { const int rho = n & 31; return (n & ~31) + 8 * ((rho & 15) >> 2) + 4 * (rho >> 4) + (rho & 3); }
DI int ppos(int c) { const int q = c & 31; return (c & ~31) + 16 * ((q >> 2) & 1) + 4 * (q >> 3) + (q & 3); }

DI void up8(const u32x4 u, f32x4& a, f32x4& b) { a = (f32x4){bflo(u.x), bfhi(u.x), bflo(u.y), bfhi(u.y)}; b = (f32x4){bflo(u.z), bfhi(u.z), bflo(u.w), bfhi(u.w)}; }
DI u32x4 pk8(const f32x4 a, const f32x4 b) { u32x4 r; r.x = pk(a[0], a[1]); r.y = pk(a[2], a[3]); r.z = pk(b[0], b[1]); r.w = pk(b[2], b[3]); return r; }

DI void slab_publish(float* slab, unsigned* flag, AccRef acc, int wid, int lane) {
    float* sp = slab + (size_t)(wid * 64 + lane) * 4;
#pragma unroll
    for (int ai = 0; ai < 2; ++ai)
#pragma unroll
        for (int bj = 0; bj < 2; ++bj)
#pragma unroll
            for (int m = 0; m < 4; ++m)
#pragma unroll
                for (int n = 0; n < 2; ++n) {
                    float* q_ = sp + (size_t)((((ai * 2 + bj) * 4 + m) * 2 + n)) * 2048; const f32x4 v_ = acc[ai][bj][m][n];
                    asm volatile("global_store_dwordx4 %0, %1, off sc0 sc1\n\ts_nop 1" :: "v"(q_), "v"(v_) : "memory"); }
    asm volatile("s_waitcnt vmcnt(0)" ::: "memory");
    if (lane == 0) __hip_atomic_store(flag + wid, 1u, __ATOMIC_RELAXED, __HIP_MEMORY_SCOPE_AGENT);
}
DI void slab_wait(unsigned* flag, int wid) {
    unsigned sp = 0;
    while (__hip_atomic_load(flag + wid, __ATOMIC_RELAXED, __HIP_MEMORY_SCOPE_AGENT) == 0u) { __builtin_amdgcn_s_sleep(2); if (++sp > (1u << 22)) break; }
    __builtin_amdgcn_fence(__ATOMIC_ACQUIRE, "agent");
    asm volatile("s_waitcnt vmcnt(0)" ::: "memory");
}
DI f32x4 slab_get(const float* slab, int ai, int bj, int m, int n, int wid, int lane) {
    return *(const f32x4*)(slab + (size_t)((((ai * 2 + bj) * 4 + m) * 2 + n)) * 2048 + (size_t)(wid * 64 + lane) * 4);
}

template <bool FIRST, bool SPLIT = false>
struct EpiRes {
    static constexpr bool IDEMP = false;
    const float* xc; const float* xl; bf16_t* Y; const float* stats; const float* lng; const float* lnb; const float* gate; float* slabs; unsigned* flags;
    DI void operator()(AccRef acc, const pg8::Unit& u, int wr, int wc, int fr, int fq) const {
        const int wid = wr * 4 + wc, lane = fr + 16 * fq;
        if (SPLIT && u.role == 1) { slab_publish(slabs + (size_t)u.slab * 65536, flags + u.slab * 8, acc, wid, lane); return; }
        const bool add = SPLIT && u.role == 2;
        const float* sl = slabs + (size_t)u.slab * 65536;
        if (add) slab_wait(flags + u.slab * 8, wid);
        const int col0 = u.pn * 256 + wc * 32 + 8 * fq;
        const float* gr = gate + cond_of(u.pm * 256) * 6144;
        f32x4 gt[2][2], lg[2][2], lb[2][2];
#pragma unroll
        for (int bj = 0; bj < 2; ++bj)
#pragma unroll
            for (int n = 0; n < 2; ++n) { const int c = col0 + bj * 128 + 4 * n; gt[bj][n] = *(const f32x4*)(gr + c);
                if (!FIRST) { lg[bj][n] = *(const f32x4*)(lng + c); lb[bj][n] = *(const f32x4*)(lnb + c); } }
#pragma unroll
        for (int ai = 0; ai < 2; ++ai)
#pragma unroll
            for (int m = 0; m < 4; ++m) {
                const int row = u.pm * 256 + ai * 128 + wr * 64 + m * 16 + fr;
                bf16_t* yr = Y + (size_t)row * DM;
                f32x2 st = {0.f, 0.f};
                if (!FIRST) st = *(const f32x2*)(stats + (size_t)row * 2);
#pragma unroll
                for (int bj = 0; bj < 2; ++bj) {
                    const int c = col0 + bj * 128;
                    f32x4 x0, x1;
                    if (FIRST) { const float* xr = row < TC ? xc + (size_t)row * DM : xl + (size_t)(row - TC) * DM; x0 = *(const f32x4*)(xr + c); x1 = *(const f32x4*)(xr + c + 4); }
                    else { up8(*(const u32x4*)(yr + c), x0, x1);
                        x0 = (x0 - st[0]) * st[1] * lg[bj][0] + lb[bj][0];
                        x1 = (x1 - st[0]) * st[1] * lg[bj][1] + lb[bj][1]; }
                    f32x4 a0 = acc[ai][bj][m][0], a1 = acc[ai][bj][m][1];
                    if (add) { a0 += slab_get(sl, ai, bj, m, 0, wid, lane); a1 += slab_get(sl, ai, bj, m, 1, wid, lane); }
                    *(u32x4*)(yr + c) = pk8(ALPHA * x0 + gt[bj][0] * a0, ALPHA * x1 + gt[bj][1] * a1);
                }
            }
    }
};

struct EpiEvenIn {
    static constexpr bool IDEMP = false;
    bf16_t* Q; bf16_t* P; bf16_t* Kc; bf16_t* VTc; bf16_t* Kl; bf16_t* VTl; float* outk; float* outv;
    const float* qg; const float* kg; const float* rope; int e;
    DI void operator()(AccRef acc, const pg8::Unit& u, int wr, int wc, int fr, int fq) const {
        const int pn = u.pn;
        if (pn >= 3) {
#pragma unroll
            for (int ai = 0; ai < 2; ++ai)
#pragma unroll
                for (int m = 0; m < 4; ++m) {
                    const int row = u.pm * 256 + ai * 128 + wr * 64 + m * 16 + fr;
                    bf16_t* pr = P + (size_t)row * 512 + (pn - 3) * 256 + wc * 32 + 8 * fq;
#pragma unroll
                    for (int bj = 0; bj < 2; ++bj)
#pragma unroll
                        for (int n = 0; n < 2; ++n) *(u32x2*)(pr + bj * 128 + n * 4) = pk4(acc[ai][bj][m][n]);
                }
            return;
        }
        const bool is_v = (pn == 2 && wc >= 2);
        const float* gw = pn < 2 ? qg : kg;
        f32x4 gh[2][2];
#pragma unroll
        for (int bj = 0; bj < 2; ++bj)
#pragma unroll
            for (int n = 0; n < 2; ++n) gh[bj][n] = *(const f32x4*)(gw + 32 * bj + 8 * fq + 4 * n);
#pragma unroll
        for (int ai = 0; ai < 2; ++ai)
#pragma unroll
            for (int m = 0; m < 4; ++m) {
                const int row = u.pm * 256 + ai * 128 + wr * 64 + m * 16 + fr;
                const bool latent = row >= TC;
                const int tpos = (row - TC) & 2047, b = (row - TC) >> 11;
                f32x4 v[2][2];
#pragma unroll
                for (int bj = 0; bj < 2; ++bj)
#pragma unroll
                    for (int n = 0; n < 2; ++n) v[bj][n] = acc[ai][bj][m][n];
                if (!is_v) {
                    float ss = 0.f;
#pragma unroll
                    for (int bj = 0; bj < 2; ++bj)
#pragma unroll
                        for (int n = 0; n < 2; ++n)
#pragma unroll
                            for (int j = 0; j < 4; ++j) ss += v[bj][n][j] * v[bj][n][j];
                    ss += __shfl_xor(ss, 16); ss += __shfl_xor(ss, 32);
                    const float rs = rsqrtf(ss * (1.0f / 64.0f) + RMS_EPS);
#pragma unroll
                    for (int bj = 0; bj < 2; ++bj)
#pragma unroll
                        for (int n = 0; n < 2; ++n) {
                            const int d = 32 * bj + 8 * fq + 4 * n;
                            v[bj][n] = v[bj][n] * rs * gh[bj][n];
                            if (latent) {
                                const f32x4 cs = *(const f32x4*)(rope + ((size_t)tpos * 32 + (d >> 1)) * 2);
                                const float x0 = v[bj][n][0], x1 = v[bj][n][1], x2 = v[bj][n][2], x3 = v[bj][n][3];
                                v[bj][n][0] = x0 * cs[0] - x1 * cs[1]; v[bj][n][1] = x0 * cs[1] + x1 * cs[0];
                                v[bj][n][2] = x2 * cs[2] - x3 * cs[3]; v[bj][n][3] = x2 * cs[3] + x3 * cs[2];
                            }
                        }
                }
                if (pn < 2) {
                    bf16_t* qr = Q + (size_t)row * 512 + (pn * 4 + wc) * 64 + 8 * fq;
#pragma unroll
                    for (int bj = 0; bj < 2; ++bj)
#pragma unroll
                        for (int n = 0; n < 2; ++n) *(u32x2*)(qr + 32 * bj + 4 * n) = pk4(v[bj][n] * QSCALE);
                } else if (!is_v) {
                    const int h = wc;
                    if (!latent) {
                        const int bb = row >> 8, t = row & 255;
                        float* ok = outk + ((size_t)(bb * 2 + e) * 256 + t) * 128 + h * 64 + 8 * fq;
                        bf16_t* kr = Kc + (size_t)row * 128 + h * 64 + 8 * fq;
#pragma unroll
                        for (int bj = 0; bj < 2; ++bj)
#pragma unroll
                            for (int n = 0; n < 2; ++n) { *(f32x4*)(ok + 32 * bj + 4 * n) = v[bj][n]; *(u32x2*)(kr + 32 * bj + 4 * n) = pk4(v[bj][n]); }
                    } else {
                        bf16_t* kr = Kl + ((size_t)b * 2304 + tpos) * 128 + h * 64 + 8 * fq;
#pragma unroll
                        for (int bj = 0; bj < 2; ++bj)
#pragma unroll
                            for (int n = 0; n < 2; ++n) *(u32x2*)(kr + 32 * bj + 4 * n) = pk4(v[bj][n]);
                    }
                } else {
                    const int h = wc - 2;
                    if (!latent) {
                        const int bb = row >> 8, t = row & 255;
                        float* ov = outv + ((size_t)(bb * 2 + e) * 256 + t) * 128 + h * 64 + 8 * fq;
                        bf16_t* vr = VTc + ((size_t)(bb * 2 + h) * 64 + 8 * fq) * 256 + t;
#pragma unroll
                        for (int bj = 0; bj < 2; ++bj)
#pragma unroll
                            for (int n = 0; n < 2; ++n) {
                                *(f32x4*)(ov + 32 * bj + 4 * n) = v[bj][n];
                                const u32x2 pv = pk4(v[bj][n]);
                                bf16_t* vp = vr + (size_t)(32 * bj + 4 * n) * 256;
                                vp[0] = (bf16_t)(pv.x & 0xffff); vp[256] = (bf16_t)(pv.x >> 16); vp[512] = (bf16_t)(pv.y & 0xffff); vp[768] = (bf16_t)(pv.y >> 16);
                            }
                    } else {
                        bf16_t* vr = VTl + ((size_t)(b * 2 + h) * 64 + 8 * fq) * 2304 + tpos;
#pragma unroll
                        for (int bj = 0; bj < 2; ++bj)
#pragma unroll
                            for (int n = 0; n < 2; ++n) {
                                const u32x2 pv = pk4(v[bj][n]);
                                bf16_t* vp = vr + (size_t)(32 * bj + 4 * n) * 2304;
                                vp[0] = (bf16_t)(pv.x & 0xffff); vp[2304] = (bf16_t)(pv.x >> 16); vp[4608] = (bf16_t)(pv.y & 0xffff); vp[6912] = (bf16_t)(pv.y >> 16);
                            }
                    }
                }
                __builtin_amdgcn_sched_barrier(0);
            }
    }
};

struct EpiOddIn {
    static constexpr bool IDEMP = false;
    bf16_t* HC; bf16_t* BG; bf16_t* XTc; bf16_t* XTl;
    DI void operator()(AccRef acc, const pg8::Unit& u, int wr, int wc, int fr, int fq) const {
        const int pn = u.pn;
#pragma unroll
        for (int ai = 0; ai < 2; ++ai)
#pragma unroll
            for (int m = 0; m < 4; ++m) {
                const int row = u.pm * 256 + ai * 128 + wr * 64 + m * 16 + fr;
                if (pn < 6) {
                    bf16_t* hr = HC + (size_t)row * 768 + pn * 128 + wc * 32 + 8 * fq;
#pragma unroll
                    for (int n = 0; n < 2; ++n) *(u32x2*)(hr + 4 * n) = pk4(acc[ai][0][m][n] * acc[ai][1][m][n]);
                } else if (pn < 9) {
                    bf16_t* br = BG + (size_t)row * 768 + (pn - 6) * 256 + wc * 32 + 8 * fq;
#pragma unroll
                    for (int bj = 0; bj < 2; ++bj)
#pragma unroll
                        for (int n = 0; n < 2; ++n) *(u32x2*)(br + bj * 128 + n * 4) = pk4(acc[ai][bj][m][n]);
                } else {
                    const int part = pn - 9;
                    bf16_t* xr; size_t cs;
                    if (row < TC) { const int bb = row >> 8, t = row & 255; cs = 512; xr = XTc + (size_t)bb * 256 * 512 + part * 256 + t; }
                    else { const int b = (row - TC) >> 11, t = (row - TC) & 2047; cs = 4096; xr = XTl + (size_t)b * 256 * 4096 + part * 2048 + t; }
#pragma unroll
                    for (int bj = 0; bj < 2; ++bj)
#pragma unroll
                        for (int n = 0; n < 2; ++n) {
                            const u32x2 pv = pk4(acc[ai][bj][m][n]);
                            bf16_t* xp = xr + (size_t)(bj * 128 + wc * 32 + n * 4 + 8 * fq) * cs;
                            xp[0] = (bf16_t)(pv.x & 0xffff); xp[cs] = (bf16_t)(pv.x >> 16); xp[2 * cs] = (bf16_t)(pv.y & 0xffff); xp[3 * cs] = (bf16_t)(pv.y >> 16);
                        }
                }
            }
    }
};

DI f32x4 silu_mul(f32x4 z, f32x4 g) {
    f32x4 y;
#pragma unroll
    for (int j = 0; j < 4; ++j) y[j] = z[j] * __builtin_amdgcn_rcpf(1.0f + __builtin_amdgcn_exp2f(-1.4426950408889634f * z[j])) * g[j];
    return y;
}
struct EpiUpConv {
    static constexpr bool IDEMP = true;
    bf16_t* Y; float* edge; const float* cw; const float* cb; LAS float* halo;
    DI void operator()(AccRef acc, const pg8::Unit& u, int wr, int wc, int fr, int fq) const {
        const int lane = fr + 16 * fq, chl = wc * 32 + 8 * fq, ch0 = u.pn * 128 + chl;
#pragma unroll
        for (int ai = 0; ai < 2; ++ai)
#pragma unroll
            for (int n = 0; n < 2; ++n) {
                if (fr == 0) *(LAS f32x4*)(halo + ((ai * 2 + wr) * 2 + 0) * 128 + chl + 4 * n) = acc[ai][0][0][n];
                if (fr == 15) *(LAS f32x4*)(halo + ((ai * 2 + wr) * 2 + 1) * 128 + chl + 4 * n) = acc[ai][0][3][n];
            }
        asm volatile("s_waitcnt lgkmcnt(0)" ::: "memory");
        __builtin_amdgcn_s_barrier(); __builtin_amdgcn_s_barrier();
        asm volatile("" ::: "memory");
        const int lprev = (lane & 48) | ((fr + 15) & 15), lnext = (lane & 48) | ((fr + 1) & 15);
        float* eg = edge + (size_t)u.pm * 6 * DFF + ch0;
#pragma unroll
        for (int n = 0; n < 2; ++n) {
            const f32x4 w0 = *(const f32x4*)(cw + ch0 + 4 * n), w1 = *(const f32x4*)(cw + DFF + ch0 + 4 * n), w2 = *(const f32x4*)(cw + 2 * DFF + ch0 + 4 * n), bb = *(const f32x4*)(cb + ch0 + 4 * n);
#pragma unroll
            for (int ai = 0; ai < 2; ++ai) {
                const int blk = ai * 2 + wr;
                f32x4 uph = {0.f, 0.f, 0.f, 0.f}, dnh = {0.f, 0.f, 0.f, 0.f};
                if (blk > 0) uph = *(const LAS f32x4*)(halo + ((blk - 1) * 2 + 1) * 128 + chl + 4 * n);
                if (blk < 3) dnh = *(const LAS f32x4*)(halo + ((blk + 1) * 2 + 0) * 128 + chl + 4 * n);
                f32x4 rr[4], rl[4];
#pragma unroll
                for (int m = 0; m < 4; ++m)
#pragma unroll
                    for (int j = 0; j < 4; ++j) { rr[m][j] = __shfl(acc[ai][0][m][n][j], lprev); rl[m][j] = __shfl(acc[ai][0][m][n][j], lnext); }
#pragma unroll
                for (int m = 0; m < 4; ++m) {
                    const f32x4 prev = fr > 0 ? rr[m] : (m > 0 ? rr[m > 0 ? m - 1 : 0] : uph);
                    const f32x4 next = fr < 15 ? rl[m] : (m < 3 ? rl[m < 3 ? m + 1 : 3] : dnh);
                    const f32x4 a = acc[ai][0][m][n], g = acc[ai][1][m][n];
                    const f32x4 z = bb + w0 * prev + w1 * a + w2 * next;
                    const int row = u.pm * 256 + ai * 128 + wr * 64 + m * 16 + fr;
                    *(u32x2*)(Y + (size_t)row * DFF + ch0 + 4 * n) = pk4(silu_mul(z, g));
                    if (ai == 0 && m == 0 && wr == 0 && fr == 0) { *(f32x4*)(eg + 4 * n) = z; *(f32x4*)(eg + DFF + 4 * n) = g; *(f32x4*)(eg + 2 * DFF + 4 * n) = a; }
                    if (ai == 1 && m == 3 && wr == 1 && fr == 15) { *(f32x4*)(eg + 3 * DFF + 4 * n) = z; *(f32x4*)(eg + 4 * DFF + 4 * n) = g; *(f32x4*)(eg + 5 * DFF + 4 * n) = a; }
                }
            }
        }
    }
};

struct EpiFourier {
    static constexpr bool IDEMP = false;
    bf16_t* mb;
    float* slabs; unsigned* flags;
    DI void operator()(AccRef acc, const pg8::Unit& u, int wr, int wc, int fr, int fq) const {
        const int wid = wr * 4 + wc, lane = fr + 16 * fq;
        if (u.role == 1) { slab_publish(slabs + (size_t)u.slab * 65536, flags + u.slab * 8, acc, wid, lane); return; }
        const bool add = u.role == 2;
        if (add) slab_wait(flags + u.slab * 8, wid);
        const float* sl = slabs + (size_t)u.slab * 65536;
#pragma unroll
        for (int ai = 0; ai < 2; ++ai)
#pragma unroll
            for (int m = 0; m < 4; ++m) {
                const int row = u.pm * 256 + ai * 128 + wr * 64 + m * 16 + fr;
                bf16_t* mr = mb + (size_t)row * DM + wc * 32 + 4 * fq;
#pragma unroll
                for (int bj = 0; bj < 2; ++bj)
#pragma unroll
                    for (int n = 0; n < 2; ++n) {
                        f32x4 a = acc[ai][bj][m][n];
                        if (add) a += slab_get(sl, ai, bj, m, n, wid, lane);
                        *(u32x2*)(mr + bj * 128 + n * 16) = pk4(a);
                    }
            }
    }
};

struct TrJob { const float* src; bf16_t* dst; int ld, Kd, k0, n0, type; };
DI int tr_srccol(int type, int np) {
    const int n = lpos(np);
    if (type == 0) return n < 768 ? ((n & ~255) + ((n >> 5) & 3) * 64 + ((n >> 7) & 1) * 32 + (n & 31)) : n;
    if (type == 1) return n < 1536 ? ((((n >> 7) & 1) ? 1536 : 0) + (n >> 8) * 128 + (n & 127)) : (768 + (n - 1536));
    if (type == 3) return (((n >> 7) & 1) ? 2816 : 0) + (n >> 8) * 128 + (n & 127);
    return n;
}

DI void convert_weights(const PRef p, const int tid, const int cc, const int GG, int l, LAS unsigned char* lds, unsigned char* wbase) {
    LAS float* t = (LAS float*)lds;
    const int G = GG, c = cc;
    const bool even = (l & 1) == 0; const int eo = l >> 1;
    bf16_t* WIN = (bf16_t*)(wbase); bf16_t* WOUT = (bf16_t*)(wbase + (OFF_WOUT - OFF_W)); bf16_t* WUP = (bf16_t*)(wbase + (OFF_WUP - OFF_W)); bf16_t* WDN = (bf16_t*)(wbase + (OFF_WDN - OFF_W));
    const float* w_out = p.in(16) + (size_t)l * 1024 * 1024;
    const float* w_up = p.in(17) + (size_t)l * 1024 * 5632;
    const float* w_dn = p.in(20) + (size_t)l * 2816 * 1024;
    const int n_in = even ? 20 * 16 : 36 * 16;
    const int n_out = even ? 16 * 8 : 16 * 16;
    const int n_up = 88 * 16, n_dn = 16 * 44;
    const int total = n_in + n_out + n_up + n_dn;
    for (int j0 = c; j0 < total; j0 += 4 * G) {
        TrJob jb[4];
#pragma unroll
        for (int qi = 0; qi < 4; ++qi) {
            int q = j0 + qi * G; TrJob J; J.type = -1; J.src = nullptr; J.dst = nullptr; J.ld = 0; J.Kd = 0; J.k0 = 0; J.n0 = 0;
            if (q < total) {
                if (q < n_in) { J.n0 = (q >> 4) * 64; J.k0 = (q & 15) * 64; J.dst = WIN; J.Kd = 1024;
                    if (even) { J.src = p.in(8) + (size_t)eo * 1024 * 1280; J.ld = 1280; J.type = 0; } else { J.src = p.in(13) + (size_t)eo * 1024 * 2560; J.ld = 2560; J.type = 1; } }
                else if ((q -= n_in) < n_out) { J.n0 = (even ? (q >> 3) : (q >> 4)) * 64; J.k0 = (even ? (q & 7) : (q & 15)) * 64; J.src = w_out; J.ld = 1024; J.dst = WOUT; J.Kd = 1024; J.type = 2; }
                else if ((q -= n_out) < n_up) { J.n0 = (q >> 4) * 64; J.k0 = (q & 15) * 64; J.src = w_up; J.ld = 5632; J.dst = WUP; J.Kd = 1024; J.type = 3; }
                else { q -= n_up; J.n0 = (q / 44) * 64; J.k0 = (q % 44) * 64; J.src = w_dn; J.ld = 1024; J.dst = WDN; J.Kd = 2816; J.type = 2; }
            }
            jb[qi] = J;
        }
        float rg[4][8];
        { const int nn = tid & 63, kk = tid >> 6;
#pragma unroll
          for (int qi = 0; qi < 4; ++qi) if (jb[qi].type >= 0) { const int sc = tr_srccol(jb[qi].type, jb[qi].n0 + nn);
#pragma unroll
              for (int i = 0; i < 8; ++i) rg[qi][i] = jb[qi].src[(size_t)(jb[qi].k0 + kk + 8 * i) * jb[qi].ld + sc]; }
#pragma unroll
          for (int qi = 0; qi < 4; ++qi) if (jb[qi].type >= 0) {
#pragma unroll
              for (int i = 0; i < 8; ++i) t[qi * 4160 + (kk + 8 * i) * 65 + nn] = rg[qi][i]; } }
        __syncthreads();
        { const int kp = tid & 31, nr = tid >> 5;
#pragma unroll
          for (int qi = 0; qi < 4; ++qi) if (jb[qi].type >= 0) {
#pragma unroll
              for (int i = 0; i < 4; ++i) { const int n = nr + 16 * i; const float a = t[qi * 4160 + (2 * kp) * 65 + n], b = t[qi * 4160 + (2 * kp + 1) * 65 + n];
                  *(unsigned*)(jb[qi].dst + (size_t)(jb[qi].n0 + n) * jb[qi].Kd + jb[qi].k0 + 2 * kp) = pk(a, b); } } }
        __syncthreads();
    }
    if (even) {
        const float* wp = p.in(11) + (size_t)eo * 4 * 128 * 128; const float* sc = p.in(12) + (size_t)eo * 512;
        for (int uu = c; uu < 256; uu += G) {
            const int g = uu >> 6, c0 = (uu & 63) * 2;
            __syncthreads();
            if (tid < 256) { const int cc = tid >> 7, d = tid & 127; t[tid] = wp[((size_t)g * 128 + c0 + cc) * 128 + d] * sc[g * 128 + d]; }
            __syncthreads();
            float a00 = 0.f, a01 = 0.f, a10 = 0.f, a11 = 0.f;
            const float* wo = w_out + (size_t)(512 + g * 128) * 1024;
#pragma unroll 8
            for (int d = 0; d < 128; ++d) {
                const float w0 = wo[(size_t)d * 1024 + tid], w1 = wo[(size_t)d * 1024 + 512 + tid];
                const float k0 = t[d], k1 = t[128 + d];
                a00 += k0 * w0; a01 += k1 * w0; a10 += k0 * w1; a11 += k1 * w1;
            }
            *(unsigned*)(WOUT + (size_t)ppos(tid) * 1024 + 512 + g * 128 + c0) = pk(a00, a01);
            *(unsigned*)(WOUT + (size_t)ppos(tid + 512) * 1024 + 512 + g * 128 + c0) = pk(a10, a11);
        }
    } else {
        const float* wf = p.in(13) + (size_t)eo * 1024 * 2560 + 2304;
        __syncthreads();
        if (tid < 64) { float s, co; sincospif((float)tid * (1.0f / 32.0f), &s, &co); t[512 + tid] = co; t[576 + tid] = s; }
        for (int uu = c; uu < 512; uu += G) {
            __syncthreads();
            t[tid] = wf[(size_t)(2 * uu + (tid >> 8)) * 2560 + (tid & 255)];
            __syncthreads();
            const int part = tid >> 8, ch = tid & 255, g = ch >> 6, mm = ch & 63;
            float a0 = 0.f, a1 = 0.f;
            for (int cc = 0; cc < 64; ++cc) { const float tw = t[512 + part * 64 + ((mm * cc) & 63)]; a0 += tw * t[g * 64 + cc]; a1 += tw * t[256 + g * 64 + cc]; }
            *(unsigned*)(WIN + (size_t)(2304 + ppos(tid)) * 1024 + 2 * uu) = pk(a0, a1);
        }
        __syncthreads();
    }
}

DI void prep_a(const PRef p, const Ctx X, LAS unsigned char* lds) {
    const int G = X.G, c = X.c, tid = X.tid, wid = tid >> 6, lane = tid & 63;
    {
        LAS float* sc = (LAS float*)lds;
        LAS float* part = sc + 9 * 1024;
        for (int i = tid; i < 9 * 1024; i += 512) { const int j = i >> 10, k = i & 1023; const float x = j == 0 ? p.in(5)[k] : p.in(4)[(size_t)(j - 1) * 1024 + k]; sc[i] = x / (1.0f + __expf(-x)); }
        __syncthreads();
        float* ada = (float*)(p.ws() + OFF_ADA);
        for (int uu = c; uu < 192; uu += G) {
            const int l = uu / 48, cb = uu % 48;
            const float* w = p.in(6) + (size_t)l * 1024 * 6144 + cb * 128 + 2 * lane;
            float a0[9], a1[9];
#pragma unroll
            for (int j = 0; j < 9; ++j) { a0[j] = 0.f; a1[j] = 0.f; }
            const int k0 = wid * 128;
#pragma unroll 16
            for (int k = 0; k < 128; ++k) { const f32x2 wv = *(const f32x2*)(w + (size_t)(k0 + k) * 6144);
#pragma unroll
                for (int j = 0; j < 9; ++j) { const float sv = sc[j * 1024 + k0 + k]; a0[j] += sv * wv[0]; a1[j] += sv * wv[1]; } }
#pragma unroll
            for (int j = 0; j < 9; ++j) *(LAS f32x2*)(part + (wid * 9 + j) * 128 + 2 * lane) = (f32x2){a0[j], a1[j]};
            __syncthreads();
            for (int i = tid; i < 9 * 128; i += 512) { const int j = i >> 7, cc = i & 127; float sm = 0.f;
#pragma unroll
                for (int w8 = 0; w8 < 8; ++w8) sm += part[(w8 * 9 + j) * 128 + cc];
                ada[((size_t)l * 9 + j) * 6144 + cb * 128 + cc] = sm + p.in(7)[(size_t)l * 6144 + cb * 128 + cc]; }
            __syncthreads();
        }
    }
    convert_weights(p, tid, c, G, 0, lds, p.ws() + OFF_W);
    const int gt = c * 512 + tid, GT = G * 512;
    {
        bf16_t* D = (bf16_t*)(p.ws() + OFF_DFT);
        const float s = 1.0f / 362.03867196751236f;
        for (int i = gt; i < 2048 * 1024; i += GT) { const int k = i >> 10, t2 = (i & 1023) * 2;
            float s0, c0, s1, c1; sincospif((float)((k * t2) & 2047) * (1.0f / 1024.0f), &s0, &c0); sincospif((float)((k * (t2 + 1)) & 2047) * (1.0f / 1024.0f), &s1, &c1);
            *(unsigned*)(D + (size_t)k * 4096 + t2) = pk(c0 * s, c1 * s); *(unsigned*)(D + (size_t)k * 4096 + 2048 + t2) = pk(-s0 * s, -s1 * s); }
        bf16_t* D2 = (bf16_t*)(p.ws() + OFF_DFT256);
        const float s2 = 1.0f / 128.0f;
        for (int i = gt; i < 256 * 128; i += GT) { const int k = i >> 7, t2 = (i & 127) * 2;
            float s0, c0, s1, c1; sincospif((float)((k * t2) & 255) * (1.0f / 128.0f), &s0, &c0); sincospif((float)((k * (t2 + 1)) & 255) * (1.0f / 128.0f), &s1, &c1);
            *(unsigned*)(D2 + (size_t)k * 512 + t2) = pk(c0 * s2, c1 * s2); *(unsigned*)(D2 + (size_t)k * 512 + 256 + t2) = pk(-s0 * s2, -s1 * s2); }
    }
    {
        float* R = (float*)(p.ws() + OFF_ROPE);
        for (int i = gt; i < 2048 * 32; i += GT) { const int t = i >> 5, f = i & 31; const float pos = (float)(f < 16 ? (t >> 6) : (t & 63));
            const float inv = 1.0f / powf(10000.0f, (float)(f & 15) * (1.0f / 16.0f)); const float ang = pos * inv; R[2 * i] = cosf(ang); R[2 * i + 1] = sinf(ang); }
    }
    {
        for (int i = gt; i < 8 * 2 * 256 * 128; i += GT) {
            const int col = i & 127, s = (i >> 7) & 255, e = (i >> 15) & 1, b = i >> 16;
            bf16_t* Kl = (bf16_t*)(p.ws() + OFF_KVL + (size_t)e * KVL_SZ); bf16_t* VTl = (bf16_t*)(p.ws() + OFF_KVL + (size_t)(2 + e) * KVL_SZ);
            const unsigned kv = pk(p.in(2)[i], 0.f), vv = pk(p.in(3)[i], 0.f);
            Kl[((size_t)b * 2304 + 2048 + s) * 128 + col] = (bf16_t)(kv & 0xffff);
            const int h = col >> 6, d = col & 63;
            VTl[((size_t)(b * 2 + h) * 64 + d) * 2304 + 2048 + s] = (bf16_t)(vv & 0xffff);
        }
    }
}

template <int MODE>
DI void ln_pass(const Ctx X, const float* srcc, const float* srcl, const bf16_t* Y, float* stats, float* xout, bf16_t* udst, const float* lng, const float* lnb, const float* adash, const float* adasc) {
    const int lane = X.tid & 63, GWV = X.G * 8, RPW = (T + GWV - 1) / GWV;
    const int gw = (X.c * 8 + (X.tid >> 6)) * RPW, rend = gw + RPW < T ? gw + RPW : T;
    const int cb = lane * 8;
    f32x4 nf[4]; u32x4 nb[2];
#define LN_LOAD(R) do { const int r_ = (R); if (MODE == 0) { const float* src = r_ < TC ? srcc + (size_t)r_ * DM : srcl + (size_t)(r_ - TC) * DM; \
            nf[0] = *(const f32x4*)(src + cb); nf[1] = *(const f32x4*)(src + cb + 4); nf[2] = *(const f32x4*)(src + cb + 512); nf[3] = *(const f32x4*)(src + cb + 516); } \
        else { nb[0] = *(const u32x4*)(Y + (size_t)r_ * DM + cb); nb[1] = *(const u32x4*)(Y + (size_t)r_ * DM + cb + 512); } } while (0)
    f32x4 hg[4], hb[4];
    if (MODE != 0) {
#pragma unroll
        for (int i = 0; i < 4; ++i) { const int c = cb + (i >> 1) * 512 + (i & 1) * 4; hg[i] = *(const f32x4*)(lng + c); hb[i] = *(const f32x4*)(lnb + c); }
    }
    if (gw < T) LN_LOAD(gw);
    int cdh = -1; f32x4 hs[4], hh[4];
    for (int row = gw; row < rend; ++row) {
        f32x4 v[4];
        if (MODE == 0) {
#pragma unroll
            for (int i = 0; i < 4; ++i) v[i] = nf[i];
        } else { up8(nb[0], v[0], v[1]); up8(nb[1], v[2], v[3]); }
        if (row + 1 < rend) LN_LOAD(row + 1);
        if (MODE != 0) {
            float s1 = 0.f, s2 = 0.f;
#pragma unroll
            for (int i = 0; i < 4; ++i)
#pragma unroll
                for (int j = 0; j < 4; ++j) { s1 += v[i][j]; s2 += v[i][j] * v[i][j]; }
#pragma unroll
            for (int o = 32; o > 0; o >>= 1) { s1 += __shfl_xor(s1, o); s2 += __shfl_xor(s2, o); }
            const float mu = s1 * (1.0f / 1024.0f);
            const float rstd = rsqrtf(fmaxf(s2 * (1.0f / 1024.0f) - mu * mu, 0.f) + LN_EPS);
            if (MODE == 1 && lane == 0) *(f32x2*)(stats + (size_t)row * 2) = (f32x2){mu, rstd};
#pragma unroll
            for (int i = 0; i < 4; ++i) { const int c = cb + (i >> 1) * 512 + (i & 1) * 4;
                v[i] = (v[i] - mu) * rstd * hg[i] + hb[i];
                if (MODE == 2) __builtin_nontemporal_store(v[i], (f32x4*)(xout + (size_t)row * DM + c)); }
        }
        if (MODE != 2) {
            float s1 = 0.f, s2 = 0.f;
#pragma unroll
            for (int i = 0; i < 4; ++i)
#pragma unroll
                for (int j = 0; j < 4; ++j) { s1 += v[i][j]; s2 += v[i][j] * v[i][j]; }
#pragma unroll
            for (int o = 32; o > 0; o >>= 1) { s1 += __shfl_xor(s1, o); s2 += __shfl_xor(s2, o); }
            const float mu = s1 * (1.0f / 1024.0f);
            const float rstd = rsqrtf(fmaxf(s2 * (1.0f / 1024.0f) - mu * mu, 0.f) + LN_EPS);
            const int cd = cond_of(row);
            if (cd != cdh) { cdh = cd;
#pragma unroll
                for (int i = 0; i < 4; ++i) { const int c = cb + (i >> 1) * 512 + (i & 1) * 4; hs[i] = 1.0f + *(const f32x4*)(adasc + cd * 6144 + c); hh[i] = *(const f32x4*)(adash + cd * 6144 + c); } }
            f32x4 o4[4];
#pragma unroll
            for (int i = 0; i < 4; ++i) o4[i] = (v[i] - mu) * rstd * hs[i] + hh[i];
            *(u32x4*)(udst + (size_t)row * DM + cb) = pk8(o4[0], o4[1]);
            *(u32x4*)(udst + (size_t)row * DM + cb + 512) = pk8(o4[2], o4[3]);
        }
    }
#undef LN_LOAD
}

constexpr int KROW = 144, VROW = 136, KBUF = 64 * KROW, VBUF = 64 * VROW, ABUF = KBUF + VBUF;
template <int VSTR>
DI void attn_tile(LAS unsigned char* kb_, LAS unsigned char* vb_, const int r, const int h, const bf16x8 (&qf)[4], f32x16 (&o)[2], float& mrun, float& lsum) {
        bf16x8 kf[2][4];
#pragma unroll
        for (int kb = 0; kb < 2; ++kb)
#pragma unroll
            for (int ks = 0; ks < 4; ++ks) kf[kb][ks] = *(const LAS bf16x8*)(kb_ + (kb * 32 + r) * KROW + (16 * ks + 8 * h) * 2);
        __builtin_amdgcn_sched_barrier(0);
        f32x16 s[2];
#pragma unroll
        for (int kb = 0; kb < 2; ++kb) {
#pragma unroll
            for (int i = 0; i < 16; ++i) s[kb][i] = 0.f;
#pragma unroll
            for (int ks = 0; ks < 4; ++ks) s[kb] = __builtin_amdgcn_mfma_f32_32x32x16_bf16(kf[kb][ks], qf[ks], s[kb], 0, 0, 0);
        }
        u32x2 vf[2][2][2][2];
#pragma unroll
        for (int kb = 0; kb < 2; ++kb)
#pragma unroll
            for (int st = 0; st < 2; ++st)
#pragma unroll
                for (int db = 0; db < 2; ++db) {
                    const LAS unsigned char* va = vb_ + (db * 32 + r) * VSTR + (kb * 32 + 16 * st + 4 * h) * 2;
                    vf[kb][st][db][0] = *(const LAS u32x2*)va; vf[kb][st][db][1] = *(const LAS u32x2*)(va + 16);
                }
        __builtin_amdgcn_sched_barrier(0);
        float mx = s[0][0];
#pragma unroll
        for (int i = 1; i < 16; ++i) mx = fmaxf(mx, s[0][i]);
#pragma unroll
        for (int i = 0; i < 16; ++i) mx = fmaxf(mx, s[1][i]);
        mx = fmaxf(mx, __shfl_xor(mx, 32));
        if (__builtin_amdgcn_ballot_w64(mx > mrun) != 0ull) {
            const float mnew = fmaxf(mrun, mx);
            const float al = __builtin_amdgcn_exp2f(mrun - mnew);
            mrun = mnew; lsum *= al;
#pragma unroll
            for (int i = 0; i < 16; ++i) { o[0][i] *= al; o[1][i] *= al; }
        }
        float ps = 0.f;
#pragma unroll
        for (int kb = 0; kb < 2; ++kb)
#pragma unroll
            for (int i = 0; i < 16; ++i) { s[kb][i] = __builtin_amdgcn_exp2f(s[kb][i] - mrun); ps += s[kb][i]; }
        lsum += ps;
        bf16x8 pf[2][2];
#pragma unroll
        for (int kb = 0; kb < 2; ++kb)
#pragma unroll
            for (int st = 0; st < 2; ++st) {
                u32x4 pp;
                pp.x = pk(s[kb][8 * st + 0], s[kb][8 * st + 1]); pp.y = pk(s[kb][8 * st + 2], s[kb][8 * st + 3]);
                pp.z = pk(s[kb][8 * st + 4], s[kb][8 * st + 5]); pp.w = pk(s[kb][8 * st + 6], s[kb][8 * st + 7]);
                pf[kb][st] = __builtin_bit_cast(bf16x8, pp);
            }
        __builtin_amdgcn_sched_barrier(0);
#pragma unroll
        for (int kb = 0; kb < 2; ++kb)
#pragma unroll
            for (int st = 0; st < 2; ++st)
#pragma unroll
                for (int db = 0; db < 2; ++db) {
                    const u32x4 vv = {vf[kb][st][db][0].x, vf[kb][st][db][0].y, vf[kb][st][db][1].x, vf[kb][st][db][1].y};
                    o[db] = __builtin_amdgcn_mfma_f32_32x32x16_bf16(__builtin_bit_cast(bf16x8, vv), pf[kb][st], o[db], 0, 0, 0);
                }
        __builtin_amdgcn_sched_barrier(0);
}

DI void attn_unit(const int tid, LAS unsigned char* lds, const bf16_t* Q, const bf16_t* Kb, const bf16_t* VTb, int Lk, bf16_t* Mo, int q0row, int kvh) {
    const int wid = tid >> 6, lane = tid & 63, r = lane & 31, h = lane >> 5;
    const int head = kvh * 4 + (wid & 3);
    const int qrow = q0row + (wid >> 2) * 32 + r;
    bf16x8 qf[4];
#pragma unroll
    for (int ks = 0; ks < 4; ++ks) qf[ks] = *(const bf16x8*)(Q + (size_t)qrow * 512 + head * 64 + 16 * ks + 8 * h);
    const int srow = tid >> 3, sch = tid & 7;
    const bf16_t* kg = Kb + (size_t)srow * 128 + sch * 8;
    const bf16_t* vg = VTb + (size_t)srow * Lk + sch * 8;
    const int nt = Lk >> 6;
    u32x4 kreg0 = *(const u32x4*)kg, vreg0 = *(const u32x4*)vg;
    u32x4 kreg1 = *(const u32x4*)(kg + (size_t)64 * 128), vreg1 = *(const u32x4*)(vg + 64);
    __syncthreads();
    *(LAS u32x4*)(lds + srow * KROW + sch * 16) = kreg0;
    *(LAS u32x2*)(lds + KBUF + srow * VROW + sch * 16) = (u32x2){vreg0.x, vreg0.y};
    *(LAS u32x2*)(lds + KBUF + srow * VROW + sch * 16 + 8) = (u32x2){vreg0.z, vreg0.w};
    __syncthreads();
    f32x16 o[2];
#pragma unroll
    for (int i = 0; i < 16; ++i) { o[0][i] = 0.f; o[1][i] = 0.f; }
    float mrun = -1e30f, lsum = 0.f;
#define ATT_STEP(T_, KCUR, VCUR, KNXT, VNXT) do { const int t = (T_); \
        LAS unsigned char* kb_ = lds + (t & 1) * ABUF; LAS unsigned char* vb_ = kb_ + KBUF; \
        if (t + 2 < nt) { KCUR = *(const u32x4*)(kg + (size_t)(t + 2) * 64 * 128); VCUR = *(const u32x4*)(vg + (t + 2) * 64); } \
        attn_tile<VROW>(kb_, vb_, r, h, qf, o, mrun, lsum); \
        if (t + 1 < nt) { LAS unsigned char* nb = lds + ((t + 1) & 1) * ABUF; \
            *(LAS u32x4*)(nb + srow * KROW + sch * 16) = KNXT; \
            *(LAS u32x2*)(nb + KBUF + srow * VROW + sch * 16) = (u32x2){VNXT.x, VNXT.y}; \
            *(LAS u32x2*)(nb + KBUF + srow * VROW + sch * 16 + 8) = (u32x2){VNXT.z, VNXT.w}; } \
        __syncthreads(); } while (0)
    for (int t2 = 0; t2 < nt; t2 += 2) {
        ATT_STEP(t2, kreg0, vreg0, kreg1, vreg1);
        ATT_STEP(t2 + 1, kreg1, vreg1, kreg0, vreg0);
    }
#undef ATT_STEP
    const float lt = lsum + __shfl_xor(lsum, 32);
    const float inv = 1.0f / lt;
    bf16_t* mo = Mo + (size_t)qrow * DM + head * 64 + 4 * h;
#pragma unroll
    for (int db = 0; db < 2; ++db)
#pragma unroll
        for (int g = 0; g < 4; ++g) {
            const f32x4 ov = {o[db][4 * g] * inv, o[db][4 * g + 1] * inv, o[db][4 * g + 2] * inv, o[db][4 * g + 3] * inv};
            *(u32x2*)(mo + db * 32 + g * 8) = pk4(ov);
        }
}

constexpr int CVS = 520, CKALL = 256 * KROW;
DI void attn_unit_ctx(const int tid, LAS unsigned char* lds, const bf16_t* Q, const bf16_t* Kb, const bf16_t* VTb, bf16_t* Mo, int q0row, int kvh) {
    const int wid = tid >> 6, lane = tid & 63, r = lane & 31, h = lane >> 5;
    const int head = kvh * 4 + (wid & 3);
    const int qrow = q0row + (wid >> 2) * 32 + r;
    bf16x8 qf[4];
#pragma unroll
    for (int ks = 0; ks < 4; ++ks) qf[ks] = *(const bf16x8*)(Q + (size_t)qrow * 512 + head * 64 + 16 * ks + 8 * h);
    const int srow = tid >> 3, sch = tid & 7;
    u32x4 kr[4], vr[4];
#pragma unroll
    for (int i = 0; i < 4; ++i) { kr[i] = *(const u32x4*)(Kb + (size_t)(srow + 64 * i) * 128 + sch * 8); vr[i] = *(const u32x4*)(VTb + (size_t)srow * 256 + (sch + 8 * i) * 8); }
    __syncthreads();
#pragma unroll
    for (int i = 0; i < 4; ++i) {
        *(LAS u32x4*)(lds + (srow + 64 * i) * KROW + sch * 16) = kr[i];
        LAS unsigned char* vp = lds + CKALL + srow * CVS + (sch + 8 * i) * 16;
        *(LAS u32x2*)vp = (u32x2){vr[i].x, vr[i].y}; *(LAS u32x2*)(vp + 8) = (u32x2){vr[i].z, vr[i].w};
    }
    __syncthreads();
    f32x16 o[2];
#pragma unroll
    for (int i = 0; i < 16; ++i) { o[0][i] = 0.f; o[1][i] = 0.f; }
    float mrun = -1e30f, lsum = 0.f;
#pragma unroll
    for (int t = 0; t < 4; ++t) attn_tile<CVS>(lds + t * 64 * KROW, lds + CKALL + t * 128, r, h, qf, o, mrun, lsum);
    const float lt = lsum + __shfl_xor(lsum, 32);
    const float inv = 1.0f / lt;
    bf16_t* mo = Mo + (size_t)qrow * DM + head * 64 + 4 * h;
#pragma unroll
    for (int db = 0; db < 2; ++db)
#pragma unroll
        for (int g = 0; g < 4; ++g) {
            const f32x4 ov = {o[db][4 * g] * inv, o[db][4 * g + 1] * inv, o[db][4 * g + 2] * inv, o[db][4 * g + 3] * inv};
            *(u32x2*)(mo + db * 32 + g * 8) = pk4(ov);
        }
}

template <int H>
DI void pool_block(const bf16_t* Pc, bf16_t* Mc, const int seq0, const int L, const int tl0) {
    unsigned v[32 + 2 * H];
#pragma unroll
    for (int i = 0; i < 32 + 2 * H; ++i) { const int j = tl0 - H + i; v[i] = (j >= 0 && j < L) ? *(const unsigned*)(Pc + (size_t)(seq0 + j) * 512) : 0u; }
    float s0 = 0.f, s1 = 0.f;
#pragma unroll
    for (int k = 0; k < 2 * H; ++k) { s0 += bflo(v[k]); s1 += bfhi(v[k]); }
#pragma unroll
    for (int i = 0; i < 32; ++i) {
        const int tl = tl0 + i;
        const int lo = tl - H > 0 ? tl - H : 0, hi = tl + H < L ? tl + H : L;
        const float ic = 1.0f / (float)(hi - lo);
        *(unsigned*)(Mc + (size_t)(seq0 + tl) * DM) = pk(s0 * ic - bflo(v[i + H]), s1 * ic - bfhi(v[i + H]));
        s0 += bflo(v[i + 2 * H]) - bflo(v[i]); s1 += bfhi(v[i + 2 * H]) - bfhi(v[i]);
    }
}

DI void mixer_even(const PRef p, const Ctx X, int e, LAS unsigned char* lds) {
    const int G = X.G, c = X.c, tid = X.tid;
    const bf16_t* Q = (const bf16_t*)(p.ws() + OFF_Q); const bf16_t* P = (const bf16_t*)(p.ws() + OFF_P);
    const bf16_t* Kc = (const bf16_t*)(p.ws() + OFF_KC); const bf16_t* VTc = (const bf16_t*)(p.ws() + OFF_VTC);
    const bf16_t* Kl = (const bf16_t*)(p.ws() + OFF_KVL + (size_t)e * KVL_SZ); const bf16_t* VTl = (const bf16_t*)(p.ws() + OFF_KVL + (size_t)(2 + e) * KVL_SZ);
    bf16_t* Mo = (bf16_t*)(p.ws() + OFF_R1);
    for (int u = c; u < 512; u += G) {
        const int pr = G == 256 ? 2 * (c & 7) + (u >> 8) : (u >> 5), qb = G == 256 ? (c >> 3) : (u & 31);
        const int b = pr >> 1, kvh = pr & 1;
        attn_unit(tid, lds, Q, Kl + (size_t)b * 2304 * 128 + kvh * 64, VTl + (size_t)(b * 2 + kvh) * 64 * 2304, 2304, Mo, TC + b * 2048 + qb * 64, kvh);
    }
    for (int u = c; u < 128; u += G) {
        const int bb = u >> 3, kvh = (u >> 2) & 1, qb = u & 3;
        attn_unit_ctx(tid, lds, Q, Kc + (size_t)bb * 256 * 128 + kvh * 64, VTc + (size_t)(bb * 2 + kvh) * 64 * 256, Mo, bb * 256 + qb * 64, kvh);
    }
    for (int u = G - 1 - c; u < 320; u += G) {
        const int row0 = u * 64 + (tid >> 8) * 32;
        const int seq0 = row0 < TC ? (row0 & ~255) : TC + ((row0 - TC) & ~2047);
        const int L = row0 < TC ? 256 : 2048;
        const int cp = tid & 255, grp = cp >> 6;
        const bf16_t* Pc = P + 2 * cp; bf16_t* Mc = Mo + 512 + 2 * cp;
        if (grp == 0) pool_block<1>(Pc, Mc, seq0, L, row0 - seq0);
        else if (grp == 1) pool_block<2>(Pc, Mc, seq0, L, row0 - seq0);
        else if (grp == 2) pool_block<4>(Pc, Mc, seq0, L, row0 - seq0);
        else pool_block<8>(Pc, Mc, seq0, L, row0 - seq0);
    }
}

DI void mixer_odd(const PRef p, const Ctx X, int o, LAS unsigned char* lds) {
    const int G = X.G, c = X.c, tid = X.tid;
    bf16_t* Mo = (bf16_t*)(p.ws() + OFF_R1);
    float* fsl = (float*)(p.ws() + OFF_R1 + 56 * MiB); unsigned* ffl = (unsigned*)(p.ws() + OFF_BAR + 16384 + 8192) + o * 1536;
    for (int j = c; j < 144; j += G) {
        pg8::Gemm g; pg8::OneUnit S; EpiFourier E; E.slabs = fsl; E.flags = ffl;
        if (j < 128) { const int prod = j < 64, base = j & 63, b = base >> 3;
            g = pg8::Gemm{(const bf16_t*)(p.ws() + OFF_DFT), (const bf16_t*)(p.ws() + OFF_XTL) + (size_t)b * 256 * 4096, 2048, 256, 4096, 4096, 4096};
            S = pg8::OneUnit{base & 7, 0, prod ? 32 : 0, 32, prod ? 1 : 2, base};
            E.mb = Mo + (size_t)(TC + b * 2048) * DM + 768; }
        else { const int bb = j - 128;
            g = pg8::Gemm{(const bf16_t*)(p.ws() + OFF_DFT256), (const bf16_t*)(p.ws() + OFF_XTC) + (size_t)bb * 256 * 512, 256, 256, 512, 512, 512};
            S = pg8::OneUnit{0, 0, 0, 8, 0, 0};
            E.mb = Mo + (size_t)(bb * 256) * DM + 768; }
        pg8::gemm_phase<EpiFourier, pg8::OneUnit>(lds, g, S, E, tid);
    }
    const bf16_t* HC = (const bf16_t*)(p.ws() + OFF_HC); const bf16_t* BG = (const bf16_t*)(p.ws() + OFF_BG);
    const float* cw = p.in(14) + (size_t)o * 3 * 768; const float* cb = p.in(15) + (size_t)o * 768;
    const int first = G >= 192 ? 128 : 0, nW = G - first;
    if (c >= first) {
        const int stride = nW * 512;
        for (int i0 = (c - first) * 512 + tid; i0 < T * 192; i0 += 4 * stride) {
            u32x2 hm[4], h0[4], hp1[4], bgv[4]; int rowq[4], q4q[4]; bool vq[4];
#pragma unroll
            for (int q = 0; q < 4; ++q) {
                const int i = i0 + q * stride; vq[q] = i < T * 192;
                const int ii = vq[q] ? i : i0;
                const int row = ii / 192, q4 = (ii % 192) * 4; rowq[q] = row; q4q[q] = q4;
                const int L = row < TC ? 256 : 2048, tl = row < TC ? (row & 255) : ((row - TC) & 2047);
                const bf16_t* hp = HC + (size_t)row * 768 + q4;
                h0[q] = *(const u32x2*)hp;
                hm[q] = tl > 0 ? *(const u32x2*)(hp - 768) : (u32x2){0u, 0u};
                hp1[q] = tl < L - 1 ? *(const u32x2*)(hp + 768) : (u32x2){0u, 0u};
                bgv[q] = *(const u32x2*)(BG + (size_t)row * 768 + q4);
            }
#pragma unroll
            for (int q = 0; q < 4; ++q) if (vq[q]) {
                const int q4 = q4q[q];
                const f32x4 w0 = *(const f32x4*)(cw + q4), w1 = *(const f32x4*)(cw + 768 + q4), w2 = *(const f32x4*)(cw + 1536 + q4), bb = *(const f32x4*)(cb + q4);
                const f32x4 z = bb + w0 * up4(hm[q]) + w1 * up4(h0[q]) + w2 * up4(hp1[q]);
                *(u32x2*)(Mo + (size_t)rowq[q] * DM + q4) = pk4(up4(bgv[q]) * z);
            }
        }
    }
}

DI void ffn_fix(const PRef p, const Ctx X, int l) {
    bf16_t* Y = (bf16_t*)(p.ws() + OFF_R1); const float* edge = (const float*)(p.ws() + OFF_EDGE);
    const float* cw = p.in(18) + (size_t)l * 3 * DFF;
    pg8::SplitOrder S; S.init(T, 1024, X.G, X.c, 2816);
    pg8::Unit u;
    for (int i = 0; S.next(i, u); ++i) {
        const int row0 = u.pm * 256;
        if (row0 < TC) continue;
        const int tl0 = (row0 - TC) & 2047;
        const float* e = edge + (size_t)u.pm * 6 * DFF;
        const bool top = tl0 != 0, bot = tl0 + 256 != 2048;
        f32x2 zt[3], gt2[3], at[3], wt[3], zb[3], gb[3], ab[3], wb[3];
#pragma unroll
        for (int k = 0; k < 3; ++k) {
            const int cp = X.tid + 512 * k, ch = 2 * cp;
            if (cp < DFF / 2) {
                if (top) { zt[k] = *(const f32x2*)(e + ch); gt2[k] = *(const f32x2*)(e + DFF + ch); at[k] = *(const f32x2*)(e - 6 * DFF + 5 * DFF + ch); wt[k] = *(const f32x2*)(cw + ch); }
                if (bot) { zb[k] = *(const f32x2*)(e + 3 * DFF + ch); gb[k] = *(const f32x2*)(e + 4 * DFF + ch); ab[k] = *(const f32x2*)(e + 6 * DFF + 2 * DFF + ch); wb[k] = *(const f32x2*)(cw + 2 * DFF + ch); }
            }
        }
#pragma unroll
        for (int k = 0; k < 3; ++k) {
            const int cp = X.tid + 512 * k, ch = 2 * cp;
            if (cp < DFF / 2) {
                if (top) {
                    const f32x4 zz = {zt[k][0] + wt[k][0] * at[k][0], zt[k][1] + wt[k][1] * at[k][1], 0.f, 0.f}, gg = {gt2[k][0], gt2[k][1], 0.f, 0.f};
                    const f32x4 y = silu_mul(zz, gg);
                    *(unsigned*)(Y + (size_t)row0 * DFF + ch) = pk(y[0], y[1]);
                }
                if (bot) {
                    const f32x4 zz = {zb[k][0] + wb[k][0] * ab[k][0], zb[k][1] + wb[k][1] * ab[k][1], 0.f, 0.f}, gg = {gb[k][0], gb[k][1], 0.f, 0.f};
                    const f32x4 y = silu_mul(zz, gg);
                    *(unsigned*)(Y + (size_t)(row0 + 255) * DFF + ch) = pk(y[0], y[1]);
                }
            }
        }
    }
    asm volatile("s_waitcnt vmcnt(0)" ::: "memory");
    __syncthreads();
}


#define XB_TMO      128
#define XB_XCNT(j)  (256  + 64 * (j))
#define XB_XSUB(j)  (1280 + 64 * (j))
#define XB_XGEN(j)  (2304 + 64 * (j))
#define XB_TOP      3328
#define XB_TOPGEN   3392
#define XCD_BAR_WORDS 3456
#define XB_SPIN_CAP (1u << 18)
DI unsigned xb_ld(unsigned* p)              { return __hip_atomic_load(p, __ATOMIC_RELAXED, __HIP_MEMORY_SCOPE_AGENT); }
DI unsigned xb_add(unsigned* p, unsigned v) { return __hip_atomic_fetch_add(p, v, __ATOMIC_RELAXED, __HIP_MEMORY_SCOPE_AGENT); }
DI unsigned xb_xcc_id() { return (unsigned)__builtin_amdgcn_s_getreg((3 << 11) | 20) & 0xFu; }
#define XB_SPIN(cond, bar) do { unsigned _sp = 0; while (cond) { __builtin_amdgcn_s_sleep(1); \
    if ((++_sp & 255u) == 0u) { if (xb_ld(&(bar)[XB_TMO])) break; if (_sp > XB_SPIN_CAP) { atomicAdd(&(bar)[XB_TMO], 1u); break; } } } } while (0)
struct XcdBarrier { unsigned* bar; unsigned x; volatile LAS unsigned* st; };
DI XcdBarrier xcd_barrier_post(unsigned* bar, volatile LAS unsigned* st) {
    XcdBarrier b; b.bar = bar; b.x = xb_xcc_id(); b.st = st;
    if (threadIdx.x == 0) (void)xb_add(&bar[XB_XCNT(b.x)], 1u);
    return b;
}
DI void xcd_barrier_complete(unsigned* bar, unsigned x, unsigned& nloc, unsigned& nx) {
    const unsigned G = gridDim.x * gridDim.y * gridDim.z;
    unsigned sum, cnt, mine, sp = 0u;
    for (;;) {
        sum = 0u; cnt = 0u; mine = 0u;
#pragma unroll
        for (unsigned j = 0; j < 16; ++j) { const unsigned c = xb_ld(&bar[XB_XCNT(j)]); sum += c; cnt += (c > 0u) ? 1u : 0u; mine = (j == x) ? c : mine; }
        if (sum == G) break;
        __builtin_amdgcn_s_sleep(1);
        if ((++sp & 255u) == 0u) { if (xb_ld(&bar[XB_TMO])) break; if (sp > XB_SPIN_CAP) { atomicAdd(&bar[XB_TMO], 1u); break; } }
    }
    nloc = mine > 0u ? mine : 1u; nx = cnt > 0u ? cnt : 1u;
}
DI void xcd_barrier(const XcdBarrier& b) {
    asm volatile("s_waitcnt vmcnt(0)" ::: "memory");
    __syncthreads();
    if (threadIdx.x == 0) {
        unsigned* bar = b.bar;
        __builtin_amdgcn_s_waitcnt(0);
        unsigned nloc = b.st[0], nx = b.st[1];
        if (nloc == 0u) { xcd_barrier_complete(bar, b.x, nloc, nx); b.st[0] = nloc; b.st[1] = nx; }
        const unsigned old = xb_add(&bar[XB_XSUB(b.x)], 1u);
        const unsigned gen = old / nloc;
        if (old + 1u == (gen + 1u) * nloc) {
            __builtin_amdgcn_fence(__ATOMIC_RELEASE, "agent");
            asm volatile("s_waitcnt vmcnt(0)" ::: "memory");
            const unsigned og = xb_add(&bar[XB_TOP], 1u);
            const unsigned tg = og / nx;
            if (og + 1u == (tg + 1u) * nx) xb_add(&bar[XB_TOPGEN], 1u);
            else XB_SPIN(xb_ld(&bar[XB_TOPGEN]) == tg, bar);
            __builtin_amdgcn_fence(__ATOMIC_ACQUIRE, "agent");
            xb_add(&bar[XB_XGEN(b.x)], 1u);
            asm volatile("s_waitcnt vmcnt(0)" ::: "memory");
        } else {
            XB_SPIN(xb_ld(&bar[XB_XGEN(b.x)]) == gen, bar);
            __builtin_amdgcn_fence(__ATOMIC_ACQUIRE, "agent");
            asm volatile("s_waitcnt vmcnt(0)" ::: "memory");
        }
    }
    __syncthreads();
}

__global__ void __launch_bounds__(512, 2) mk_fwd(Params p_) {
    extern __shared__ __attribute__((aligned(16))) unsigned char lds_raw[];
    cg::grid_group grid = cg::this_grid();
    const int ph_lo = p_.ph_lo, ph_hi = p_.ph_hi;
    XcdBarrier xbar; xbar.bar = nullptr; xbar.x = 0; xbar.st = nullptr;
    if (ph_hi - ph_lo > 1) {
        volatile LAS unsigned* st = (volatile LAS unsigned*)((LAS unsigned char*)lds_raw + XBST_OFF);
        if (threadIdx.x == 0) { st[0] = 0u; st[1] = 0u; }
        __syncthreads();
        xbar = xcd_barrier_post((unsigned*)(p_.ws + OFF_BAR), st);
    }
    unsigned long long pr_prev = PROBE_CATS ? __builtin_amdgcn_s_memrealtime() : 0ull, pr_acc = 0ull;
    for (int ph = ph_lo; ph < ph_hi; ++ph) {
        Ctx X; X.tid = threadIdx.x; X.c = blockIdx.x; X.G = gridDim.x;
        asm volatile("" : "+v"(X.tid)); asm volatile("" : "+s"(X.c)); asm volatile("" : "+s"(X.G));
#if defined(__HIP_DEVICE_COMPILE__)
        ParamsPtr pp = (ParamsPtr)__builtin_amdgcn_kernarg_segment_ptr();
        asm volatile("" : "+s"(pp));
#else
        ParamsPtr pp = &p_;
#endif
        const PRef p{pp};
        unsigned lds_u = 0; asm volatile("" : "+s"(lds_u));
        LAS unsigned char* lds = (LAS unsigned char*)lds_raw + lds_u;
        const int G = X.G, c = X.c, tid = X.tid;
        bf16_t* YB = (bf16_t*)(p.ws() + OFF_XB);
        float* STATS = (float*)(p.ws() + OFF_STATS);
        bf16_t* UM = (bf16_t*)(p.ws() + OFF_R1);
        bf16_t* U2 = (bf16_t*)(p.ws() + OFF_R2);
        const float* ada = (const float*)(p.ws() + OFF_ADA);
        if (EN(0) && ph == 0) prep_a(p, X, lds);
        else if (EN(1) && ph == 1) ln_pass<0>(X, p.in(0), p.in(1), nullptr, nullptr, nullptr, UM, nullptr, nullptr, ada + 0, ada + 1024);
        else {
            const int l = (ph - 2) / NSUB, sub = (ph - 2) % NSUB;
            const bool even = (l & 1) == 0; const int eo = l >> 1;
            const float* adal = ada + (size_t)l * 9 * 6144;
            unsigned char* wset = p.ws() + ((l & 1) ? OFF_W2 : OFF_W);
            if (sub == 0) {
                if (EN(2) && even) {
                    pg8::Gemm g{UM, (const bf16_t*)(wset + (OFF_WIN - OFF_W)), T, 1280, 1024, 1024, 1024}; pg8::StaticOrder S; S.init(T, 1280, G, c, 1024);
                    EpiEvenIn E{(bf16_t*)(p.ws() + OFF_Q), (bf16_t*)(p.ws() + OFF_P), (bf16_t*)(p.ws() + OFF_KC), (bf16_t*)(p.ws() + OFF_VTC),
                                (bf16_t*)(p.ws() + OFF_KVL + (size_t)eo * KVL_SZ), (bf16_t*)(p.ws() + OFF_KVL + (size_t)(2 + eo) * KVL_SZ),
                                p.out() + 20971520, p.out() + 22020096, p.in(9) + eo * 64, p.in(10) + eo * 64, (const float*)(p.ws() + OFF_ROPE), eo};
                    pg8::gemm_phase<EpiEvenIn, pg8::StaticOrder>(lds, g, S, E, tid);
                } else if (EN(3)) {
                    pg8::Gemm g{UM, (const bf16_t*)(wset + (OFF_WIN - OFF_W)), T, 2816, 1024, 1024, 1024}; pg8::StaticOrder S; S.init(T, 2816, G, c, 1024);
                    EpiOddIn E{(bf16_t*)(p.ws() + OFF_HC), (bf16_t*)(p.ws() + OFF_BG), (bf16_t*)(p.ws() + OFF_XTC), (bf16_t*)(p.ws() + OFF_XTL)};
                    pg8::gemm_phase<EpiOddIn, pg8::StaticOrder>(lds, g, S, E, tid);
                }
            } else if (sub == 1) {
                if (EN(4) && even) mixer_even(p, X, eo, lds); else if (EN(5) && !even) mixer_odd(p, X, eo, lds);
            } else if (EN(6) && sub == 2) {
                pg8::Gemm g{UM, (const bf16_t*)(wset + (OFF_WOUT - OFF_W)), T, 1024, 1024, 1024, 1024}; pg8::StaticOrder S; S.init(T, 1024, G, c, 1024);
                if (l == 0) { EpiRes<true> E{p.in(0), p.in(1), YB, nullptr, nullptr, nullptr, adal + 2048, nullptr, nullptr};
                    pg8::gemm_phase<EpiRes<true>, pg8::StaticOrder>(lds, g, S, E, tid); }
                else { EpiRes<false> E{nullptr, nullptr, YB, STATS, p.in(21) + (size_t)(l * 2 - 1) * 1024, p.in(22) + (size_t)(l * 2 - 1) * 1024, adal + 2048, nullptr, nullptr};
                    pg8::gemm_phase<EpiRes<false>, pg8::StaticOrder>(lds, g, S, E, tid); }
            } else if (EN(7) && sub == 3) {
                ln_pass<1>(X, nullptr, nullptr, YB, STATS, nullptr, U2, p.in(21) + (size_t)(l * 2) * 1024, p.in(22) + (size_t)(l * 2) * 1024, adal + 3072, adal + 4096);
            } else if (EN(8) && sub == 4) {
                pg8::Gemm g{U2, (const bf16_t*)(wset + (OFF_WUP - OFF_W)), T, 5632, 1024, 1024, 1024}; pg8::StaticOrder S; S.init(T, 5632, G, c, 1024);
                EpiUpConv E{(bf16_t*)(p.ws() + OFF_R1), (float*)(p.ws() + OFF_EDGE), p.in(18) + (size_t)l * 3 * DFF, p.in(19) + (size_t)l * DFF, (LAS float*)(lds + HALO_OFF)};
                pg8::gemm_phase<EpiUpConv, pg8::StaticOrder>(lds, g, S, E, tid);
            } else if (EN(10) && sub == 5) {
                ffn_fix(p, X, l);
                pg8::Gemm g{(const bf16_t*)(p.ws() + OFF_R1), (const bf16_t*)(wset + (OFF_WDN - OFF_W)), T, 1024, 2816, 2816, 2816}; pg8::SplitOrder S; S.init(T, 1024, G, c, 2816);
                EpiRes<false, true> E{nullptr, nullptr, YB, STATS, p.in(21) + (size_t)(l * 2) * 1024, p.in(22) + (size_t)(l * 2) * 1024, adal + 5120,
                                      (float*)(p.ws() + OFF_R2), (unsigned*)(p.ws() + OFF_BAR + 16384) + l * 512};
                pg8::gemm_phase<EpiRes<false, true>, pg8::SplitOrder>(lds, g, S, E, tid);
                if (l < 3) {
                    const int n2 = G == 256 ? 128 : ((T / 256) * 4 > G ? (T / 256) * 4 - G : 0);
                    if (G - n2 >= 64) { if (c >= n2) convert_weights(p, tid, c - n2, G - n2, l + 1, lds, p.ws() + (((l + 1) & 1) ? OFF_W2 : OFF_W)); }
                    else convert_weights(p, tid, c, G, l + 1, lds, p.ws() + (((l + 1) & 1) ? OFF_W2 : OFF_W));
                }
            } else if (EN(11) && sub == 6) {
                const float* lg = p.in(21) + (size_t)(l * 2 + 1) * 1024; const float* lb = p.in(22) + (size_t)(l * 2 + 1) * 1024;
                if (l == 3) ln_pass<2>(X, nullptr, nullptr, YB, STATS, p.out(), nullptr, lg, lb, nullptr, nullptr);
                else ln_pass<1>(X, nullptr, nullptr, YB, STATS, nullptr, UM, lg, lb, adal + 9 * 6144 + 0, adal + 9 * 6144 + 1024);
            }
        }
        if (ph + 1 < ph_hi) { if (ph_hi < 0) grid.sync(); else xcd_barrier(xbar); }
        if (PROBE_CATS) {
            const int sub_ = ph < 2 ? -1 : (ph - 2) % NSUB, l_ = ph < 2 ? 0 : (ph - 2) / NSUB;
            const int cat = ph == 0 ? 0 : ph == 1 ? 1 : sub_ == 0 ? 2 : sub_ == 1 ? ((l_ & 1) ? 4 : 3) : sub_ == 2 ? 5 : (sub_ == 3 || sub_ == 6) ? 1 : sub_ == 4 ? 6 : 8;
            const unsigned long long now = __builtin_amdgcn_s_memrealtime();
            if ((PROBE_CATS >> cat) & 1) pr_acc += now - pr_prev;
            pr_prev = now;
        }
    }
    if (PROBE_CATS && blockIdx.x == 0) {
        const unsigned long long t0 = __builtin_amdgcn_s_memrealtime();
        while (__builtin_amdgcn_s_memrealtime() - t0 < pr_acc) __builtin_amdgcn_s_sleep(8);
    }
}

extern "C" void kernel_launch(void* const* d_in, const int* in_sizes, int n_in, void* d_out, int out_size, void* d_ws, size_t ws_size, hipStream_t stream) {
    static int grid = 0;
    if (grid == 0) {
        int dev = 0, cus = 0, per_cu = 0;
        (void)hipGetDevice(&dev);
        (void)hipDeviceGetAttribute(&cus, hipDeviceAttributeMultiprocessorCount, dev);
        (void)hipFuncSetAttribute((const void*)mk_fwd, hipFuncAttributeMaxDynamicSharedMemorySize, LDS_BYTES);
        (void)hipOccupancyMaxActiveBlocksPerMultiprocessor(&per_cu, (const void*)mk_fwd, 512, LDS_BYTES);
        if (per_cu < 1) { fprintf(stderr, "kernel_launch: occupancy query reports %d blocks per CU\n", per_cu); per_cu = 1; }
        (void)hipGetLastError();
        grid = cus;
        if (n_in != 23 || ws_size < WS_END) { fprintf(stderr, "kernel_launch: n_in %d ws %zu (need %zu)\n", n_in, ws_size, (size_t)WS_END); }
    }
    Params p{};
    for (int i = 0; i < 23; ++i) p.in[i] = (const float*)d_in[i];
    p.out = (float*)d_out; p.ws = (unsigned char*)d_ws;
#if MULTI_LAUNCH
    for (int ph = 0; ph < NPH; ++ph) { p.ph_lo = ph; p.ph_hi = ph + 1; hipLaunchKernelGGL(mk_fwd, dim3(grid), dim3(512), LDS_BYTES, stream, p); }
#else
    p.ph_lo = 0; p.ph_hi = NPH;
    (void)hipMemsetAsync((unsigned char*)d_ws + OFF_BAR, 0, 16384 + 8192 + 12288, stream);
    void* args[] = {&p};
    hipError_t e = hipLaunchCooperativeKernel((const void*)mk_fwd, dim3(grid), dim3(512), args, LDS_BYTES, stream);
    if (e != hipSuccess) fprintf(stderr, "cooperative launch failed: %s (grid %d)\n", hipGetErrorString(e), grid);
#endif
}
```

```cpp
#include <hip/hip_runtime.h>
#include <hip/hip_cooperative_groups.h>
#include <cstdio>
namespace cg = cooperative_groups;

#ifndef PHMASK
#define PHMASK 0xffff
#endif
#define EN(b) ((PHMASK >> (b)) & 1)
#ifndef PROBE_CATS
#define PROBE_CATS 0
#endif
#ifndef MULTI_LAUNCH
#define MULTI_LAUNCH 0
#endif

#define DI __device__ __forceinline__
#define LAS __attribute__((address_space(3)))
typedef unsigned short bf16_t;
typedef short bf16x8 __attribute__((ext_vector_type(8)));
typedef float f32x4 __attribute__((ext_vector_type(4)));
typedef float f32x2 __attribute__((ext_vector_type(2)));
typedef float f32x16 __attribute__((ext_vector_type(16)));
typedef unsigned u32x4 __attribute__((ext_vector_type(4)));
typedef unsigned u32x2 __attribute__((ext_vector_type(2)));
typedef __bf16 bf2_t __attribute__((ext_vector_type(2)));

constexpr int T = 20480, TC = 4096, DM = 1024;
constexpr int DFF = 2816;
constexpr int CH = 10240;
constexpr float ALPHA = 1.6817928305074292f;
constexpr float LN_EPS = 1e-6f, RMS_EPS = 1e-6f;
constexpr float QSCALE = 0.125f * 1.4426950408889634f;
constexpr size_t MiB = 1048576;
constexpr size_t OFF_XB = 0;
constexpr size_t OFF_R1 = 80 * MiB;
constexpr size_t OFF_GB = OFF_R1 + 55 * MiB;
constexpr size_t OFF_R2 = 190 * MiB;
constexpr size_t OFF_Q = OFF_R2, OFF_P = OFF_R2 + 20 * MiB, OFF_KC = OFF_R2 + 40 * MiB, OFF_VTC = OFF_R2 + 41 * MiB;
constexpr size_t OFF_HC = OFF_R2, OFF_BG = OFF_R2 + 30 * MiB, OFF_XTC = OFF_R2 + 60 * MiB, OFF_XTL = OFF_R2 + 64 * MiB;
constexpr size_t OFF_W = 270 * MiB;
constexpr size_t OFF_WIN = OFF_W, OFF_WOUT = OFF_W + 11 * MiB / 2, OFF_WUP = OFF_W + 15 * MiB / 2, OFF_WDN = OFF_W + 37 * MiB / 2;
constexpr size_t OFF_DFT = 294 * MiB;
constexpr size_t OFF_DFT256 = OFF_DFT + 16 * MiB;
constexpr size_t OFF_KVL = 311 * MiB;
constexpr size_t KVL_SZ = (size_t)8 * 2304 * 128 * 2;
constexpr size_t OFF_ADA = 329 * MiB;
constexpr size_t OFF_ROPE = 330 * MiB;
constexpr size_t OFF_EDGE = 331 * MiB;
constexpr size_t OFF_STATS = 337 * MiB;
constexpr size_t OFF_W2 = 338 * MiB;
constexpr size_t OFF_BAR = 362 * MiB;
constexpr size_t WS_END = 363 * MiB;
constexpr int HALO_OFF = 131072;
constexpr int XBST_OFF = 131072 + 4096;
constexpr int LDS_BYTES = 131072 + 4096 + 16;
constexpr int NSUB = 7;
constexpr int NPH = 2 + 4 * NSUB;

struct Params { const float* in[23]; float* out; unsigned char* ws; int ph_lo, ph_hi; };
#if defined(__HIP_DEVICE_COMPILE__)
typedef const __attribute__((address_space(4))) Params* ParamsPtr;
#else
typedef const Params* ParamsPtr;
#endif
struct PRef {
    ParamsPtr q;
    DI const float* in(int k) const { return q->in[k]; }
    DI float* out() const { return q->out; }
    DI unsigned char* ws() const { return q->ws; }
};
struct Ctx { int tid, c, G; };

DI unsigned pk(float lo, float hi) { f32x2 v = {lo, hi}; return __builtin_bit_cast(unsigned, __builtin_convertvector(v, bf2_t)); }
DI float bflo(unsigned u) { return __uint_as_float(u << 16); }
DI float bfhi(unsigned u) { return __uint_as_float(u & 0xffff0000u); }
DI u32x2 pk4(f32x4 v) { u32x2 r; r.x = pk(v[0], v[1]); r.y = pk(v[2], v[3]); return r; }
DI f32x4 up4(u32x2 u) { f32x4 r = {bflo(u.x), bfhi(u.x), bflo(u.y), bfhi(u.y)}; return r; }
DI int cond_of(int row) { return row < TC ? 0 : 1 + ((row - TC) >> 11); }
DI float wsum(float v) {
#pragma unroll
    for (int o = 32; o > 0; o >>= 1) v += __shfl_xor(v, o);
    return v;
}

namespace pg8 {
constexpr int BM = 256, BK = 64, HALF = 128, HTB = HALF * BK * 2, STAGE_BYTES = 8 * HTB, NXCD = 8, WGM = 8;
DI int lds_byte(int r, int c) { const int st = (r >> 4) * 2 + (c >> 5), rr = r & 15, cc = c & 31, ob = rr * 64 + cc * 2; return st * 1024 + (ob ^ (((ob >> 9) & 1) << 5)); }
DI void stage_rc(int b, int& R, int& C) { const int st = b / 1024, sb = b % 1024, swz = sb ^ (((sb >> 9) & 1) << 5); R = (st >> 1) * 16 + swz / 64; C = (st & 1) * 32 + (swz % 64) / 2; }
struct Unit { int pm, pn, kt0, nt, role, slab; };
struct Gemm { const bf16_t* A; const bf16_t* Bt; int M, N, K, lda, ldb; };
struct StaticOrder {
    int nM, nN, nwg, G, c, nt0;
    DI void init(int M, int N, int G_, int c_, int K_ = 1024) { nM = M / BM; nN = N / BM; nwg = nM * nN; G = G_; c = c_; nt0 = K_ / BK; }
    DI bool unit_of(long L, Unit& u) const {
        if (L >= nwg) return false;
        u.kt0 = 0; u.nt = nt0; u.role = 0; u.slab = 0;
        int wgid = (int)L; { const int q = nwg / NXCD, r = nwg % NXCD, xcd = wgid % NXCD, off = wgid / NXCD; wgid = (xcd < r ? xcd * (q + 1) : r * (q + 1) + (xcd - r) * q) + off; }
        const int nig = WGM * nN, gid = wgid / nig, fm = gid * WGM, gsz = (nM - fm) < WGM ? (nM - fm) : WGM;
        u.pm = fm + ((wgid % nig) % gsz); u.pn = (wgid % nig) / gsz; return true;
    }
    DI bool next(int i, Unit& u) const { return unit_of((long)i * G + c, u); }
    DI void a_ready(const Unit&) const {}
    DI void done(const Unit&) const {}
};
struct SplitOrder : StaticOrder {
    DI bool next(int i, Unit& u) const {
        if (G != 256 || nwg != 320) return unit_of((long)i * G + c, u);
        if (i == 0) return unit_of(c, u);
        if (i != 1 || c >= 128) return false;
        unit_of(256 + (c & 63), u); const int h = c >> 6; u.nt = nt0 / 2; u.kt0 = h * (nt0 / 2); u.role = h ? 1 : 2; u.slab = c & 63; return true;
    }
};
struct OneUnit {
    int pm, pn, kt0, nt, role, slab;
    DI bool next(int i, Unit& u) const { if (i != 0) return false; u.pm = pm; u.pn = pn; u.kt0 = kt0; u.nt = nt; u.role = role; u.slab = slab; return true; }
    DI void a_ready(const Unit&) const {}
    DI void done(const Unit&) const {}
};

template <class Epi, class Sched>
DI void gemm_phase(LAS unsigned char* lds, const Gemm g, const Sched& S, const Epi& E, const int tid) {
    const int wid = __builtin_amdgcn_readfirstlane(tid >> 6), lane = tid & 63, wr = wid >> 2, wc = wid & 3, fr = lane & 15, fq = lane >> 4;
    unsigned voffA[2], voffB[2];
#pragma unroll
    for (int i = 0; i < 2; ++i) { int R, C; stage_rc(tid * 16 + i * 8192, R, C); voffA[i] = (unsigned)(R * g.lda + C) * 2u; voffB[i] = (unsigned)(R * g.ldb + C) * 2u; }
    const size_t kstep = (size_t)(BK * 2);
    const size_t hstepA = (size_t)HALF * g.lda * 2, hstepB = (size_t)HALF * g.ldb * 2;
    const size_t tstepA = 2 * hstepA, tstepB = 2 * hstepB;
    const unsigned ldsw = (unsigned)wid * 1024u;
    const int aoff = lds_byte(wr * 64 + fr, fq * 8), boff = lds_byte(wc * 32 + fr, fq * 8);
#define PG8_SA(b, h) (((b) * 2 + (h)) * HTB)
#define PG8_SB(b, h) ((4 + (b) * 2 + (h)) * HTB)
#define PG8_STAGE(bufoff, gbase, voff) do { _Pragma("unroll") for (int _i = 0; _i < 2; ++_i) \
        __builtin_amdgcn_global_load_lds((const unsigned*)((const char*)(gbase) + (voff)[_i]), (LAS unsigned*)(lds + (bufoff) + ldsw + _i * 8192), 16, 0, 0); } while (0)
#define PG8_LDA(dst, b, h) do { _Pragma("unroll") for (int m = 0; m < 4; ++m) _Pragma("unroll") for (int k = 0; k < 2; ++k) dst[m][k] = *(const LAS bf16x8*)(lds + PG8_SA(b, h) + aoff + m * 2048 + k * 1024); } while (0)
#define PG8_LDB(dst, b, h) do { _Pragma("unroll") for (int n = 0; n < 2; ++n) _Pragma("unroll") for (int k = 0; k < 2; ++k) dst[n][k] = *(const LAS bf16x8*)(lds + PG8_SB(b, h) + boff + n * 2048 + k * 1024); } while (0)
#define PG8_MMA(ai, bj, At, Bt) do { __builtin_amdgcn_s_setprio(1); _Pragma("unroll") for (int m = 0; m < 4; ++m) _Pragma("unroll") for (int n = 0; n < 2; ++n) _Pragma("unroll") for (int k = 0; k < 2; ++k) \
        acc[ai][bj][m][n] = __builtin_amdgcn_mfma_f32_16x16x32_bf16(Bt[n][k], At[m][k], acc[ai][bj][m][n], 0, 0, 0); __builtin_amdgcn_s_setprio(0); } while (0)
#define PG8_WAIT_V(n) asm volatile("s_waitcnt vmcnt(" #n ")" ::: "memory")
#define PG8_WAIT_L(n) asm volatile("s_waitcnt lgkmcnt(" #n ")" ::: "memory")
#define PG8_BAR __builtin_amdgcn_s_barrier()
#define PG8_SCHED __builtin_amdgcn_sched_barrier(0)
    Unit cur, nxt; int ui = 0;
    if (!S.next(0, cur)) return;
    f32x4 acc[2][2][4][2];
#pragma unroll
    for (int a = 0; a < 2; ++a)
#pragma unroll
        for (int b = 0; b < 2; ++b)
#pragma unroll
            for (int m = 0; m < 4; ++m)
#pragma unroll
                for (int n = 0; n < 2; ++n) acc[a][b][m][n] = (f32x4){0.f, 0.f, 0.f, 0.f};
    bf16x8 At[4][2], B0[2][2], B1[2][2];
    const char* cA = (const char*)g.A + (size_t)cur.pm * tstepA + (size_t)cur.kt0 * kstep; const char* cB = (const char*)g.Bt + (size_t)cur.pn * tstepB + (size_t)cur.kt0 * kstep;
    S.a_ready(cur);
    PG8_STAGE(PG8_SB(0, 0), cB, voffB); PG8_STAGE(PG8_SA(0, 0), cA, voffA); PG8_STAGE(PG8_SB(0, 1), cB + hstepB, voffB); PG8_STAGE(PG8_SA(0, 1), cA + hstepA, voffA);
    if (wr == 1) PG8_BAR;
    PG8_WAIT_V(4); PG8_BAR;
    PG8_STAGE(PG8_SB(1, 0), cB + kstep, voffB); PG8_STAGE(PG8_SA(1, 0), cA + kstep, voffA); PG8_STAGE(PG8_SB(1, 1), cB + hstepB + kstep, voffB);
    PG8_WAIT_V(6); PG8_BAR;
    for (;;) {
        const bool has_next = S.next(ui + 1, nxt);
        const char* nA = has_next ? (const char*)g.A + (size_t)nxt.pm * tstepA + (size_t)nxt.kt0 * kstep : cA; const char* nB = has_next ? (const char*)g.Bt + (size_t)nxt.pn * tstepB + (size_t)nxt.kt0 * kstep : cB;
        const int nt = cur.nt;
        for (int t = 0; t < nt; t += 2) {
            const bool last = (t == nt - 2);
            const char* a1 = cA + (size_t)(t + 1) * kstep;
            const char* a2 = last ? nA : cA + (size_t)(t + 2) * kstep; const char* b2 = last ? nB : cB + (size_t)(t + 2) * kstep;
            const char* a3 = a2 + kstep; const char* b3 = b2 + kstep;
            if (last && has_next) S.a_ready(nxt);
            PG8_LDB(B0, 0, 0); PG8_SCHED; PG8_LDA(At, 0, 0); PG8_STAGE(PG8_SA(1, 1), a1 + hstepA, voffA);
            PG8_WAIT_L(8); PG8_BAR; PG8_WAIT_L(0); PG8_MMA(0, 0, At, B0); PG8_BAR; PG8_SCHED;
            PG8_LDB(B1, 0, 1); PG8_STAGE(PG8_SB(0, 0), b2, voffB);
            PG8_BAR; PG8_WAIT_L(0); PG8_MMA(0, 1, At, B1); PG8_BAR;
            PG8_LDA(At, 0, 1); PG8_STAGE(PG8_SA(0, 0), a2, voffA);
            PG8_BAR; PG8_WAIT_L(0); PG8_MMA(1, 0, At, B0); PG8_BAR; PG8_SCHED;
            PG8_STAGE(PG8_SB(0, 1), b2 + hstepB, voffB);
            PG8_WAIT_V(6); PG8_BAR; PG8_MMA(1, 1, At, B1); PG8_BAR;
            PG8_LDB(B0, 1, 0); PG8_SCHED; PG8_LDA(At, 1, 0); PG8_STAGE(PG8_SA(0, 1), a2 + hstepA, voffA);
            PG8_WAIT_L(8); PG8_BAR; PG8_WAIT_L(0); PG8_MMA(0, 0, At, B0); PG8_BAR; PG8_SCHED;
            PG8_LDB(B1, 1, 1); PG8_STAGE(PG8_SB(1, 0), b3, voffB);
            PG8_BAR; PG8_WAIT_L(0); PG8_MMA(0, 1, At, B1); PG8_BAR;
            PG8_LDA(At, 1, 1); PG8_STAGE(PG8_SA(1, 0), a3, voffA);
            PG8_BAR; PG8_WAIT_L(0); PG8_MMA(1, 0, At, B0); PG8_BAR; PG8_SCHED;
            PG8_STAGE(PG8_SB(1, 1), b3 + hstepB, voffB);
            PG8_WAIT_V(6); PG8_BAR; PG8_MMA(1, 1, At, B1); PG8_BAR;
        }
        E(acc, cur, wr, wc, fr, fq); S.done(cur);
#if defined(PROBE_EPI2)
        if constexpr (Epi::IDEMP) E(acc, cur, wr, wc, fr, fq);
#endif
        if (!has_next) break;
#pragma unroll
        for (int a = 0; a < 2; ++a)
#pragma unroll
            for (int b = 0; b < 2; ++b)
#pragma unroll
                for (int m = 0; m < 4; ++m)
#pragma unroll
                    for (int n = 0; n < 2; ++n) acc[a][b][m][n] = (f32x4){0.f, 0.f, 0.f, 0.f};
        cur = nxt; cA = nA; cB = nB; ++ui;
    }
    PG8_WAIT_V(0);
    if (wr == 0) PG8_BAR;
    PG8_BAR;
#undef PG8_SA
#undef PG8_SB
#undef PG8_STAGE
#undef PG8_LDA
#undef PG8_LDB
#undef PG8_MMA
#undef PG8_WAIT_V
#undef PG8_WAIT_L
#undef PG8_BAR
#undef PG8_SCHED
}
}

typedef const f32x4 (&AccRef)[2][2][4][2];
DI int lpos(int n) { const int rho = n & 31; return (n & ~31) + 8 * ((rho & 15) >> 2) + 4 * (rho >> 4) + (rho & 3); }
DI int ppos(int c) { const int q = c & 31; return (c & ~31) + 16 * ((q >> 2) & 1) + 4 * (q >> 3) + (q & 3); }

DI void up8(const u32x4 u, f32x4& a, f32x4& b) { a = (f32x4){bflo(u.x), bfhi(u.x), bflo(u.y), bfhi(u.y)}; b = (f32x4){bflo(u.z), bfhi(u.z), bflo(u.w), bfhi(u.w)}; }
DI u32x4 pk8(const f32x4 a, const f32x4 b) { u32x4 r; r.x = pk(a[0], a[1]); r.y = pk(a[2], a[3]); r.z = pk(b[0], b[1]); r.w = pk(b[2], b[3]); return r; }

DI void slab_publish(float* slab, unsigned* flag, AccRef acc, int wid, int lane) {
    float* sp = slab + (size_t)(wid * 64 + lane) * 4;
#pragma unroll
    for (int ai = 0; ai < 2; ++ai)
#pragma unroll
        for (int bj = 0; bj < 2; ++bj)
#pragma unroll
            for (int m = 0; m < 4; ++m)
#pragma unroll
                for (int n = 0; n < 2; ++n) {
                    float* q_ = sp + (size_t)((((ai * 2 + bj) * 4 + m) * 2 + n)) * 2048; const f32x4 v_ = acc[ai][bj][m][n];
                    asm volatile("global_store_dwordx4 %0, %1, off sc0 sc1\n\ts_nop 1" :: "v"(q_), "v"(v_) : "memory"); }
    asm volatile("s_waitcnt vmcnt(0)" ::: "memory");
    if (lane == 0) __hip_atomic_store(flag + wid, 1u, __ATOMIC_RELAXED, __HIP_MEMORY_SCOPE_AGENT);
}
DI void slab_wait(unsigned* flag, int wid) {
    unsigned sp = 0;
    while (__hip_atomic_load(flag + wid, __ATOMIC_RELAXED, __HIP_MEMORY_SCOPE_AGENT) == 0u) { __builtin_amdgcn_s_sleep(2); if (++sp > (1u << 22)) break; }
    __builtin_amdgcn_fence(__ATOMIC_ACQUIRE, "agent");
    asm volatile("s_waitcnt vmcnt(0)" ::: "memory");
}
DI f32x4 slab_get(const float* slab, int ai, int bj, int m, int n, int wid, int lane) {
    return *(const f32x4*)(slab + (size_t)((((ai * 2 + bj) * 4 + m) * 2 + n)) * 2048 + (size_t)(wid * 64 + lane) * 4);
}

template <bool FIRST, bool SPLIT = false>
struct EpiRes {
    static constexpr bool IDEMP = false;
    const float* xc; const float* xl; bf16_t* Y; const float* stats; const float* lng; const float* lnb; const float* gate; float* slabs; unsigned* flags;
    DI void operator()(AccRef acc, const pg8::Unit& u, int wr, int wc, int fr, int fq) const {
        const int wid = wr * 4 + wc, lane = fr + 16 * fq;
        if (SPLIT && u.role == 1) { slab_publish(slabs + (size_t)u.slab * 65536, flags + u.slab * 8, acc, wid, lane); return; }
        const bool add = SPLIT && u.role == 2;
        const float* sl = slabs + (size_t)u.slab * 65536;
        if (add) slab_wait(flags + u.slab * 8, wid);
        const int col0 = u.pn * 256 + wc * 32 + 8 * fq;
        const float* gr = gate + cond_of(u.pm * 256) * 6144;
        f32x4 gt[2][2], lg[2][2], lb[2][2];
#pragma unroll
        for (int bj = 0; bj < 2; ++bj)
#pragma unroll
            for (int n = 0; n < 2; ++n) { const int c = col0 + bj * 128 + 4 * n; gt[bj][n] = *(const f32x4*)(gr + c);
                if (!FIRST) { lg[bj][n] = *(const f32x4*)(lng + c); lb[bj][n] = *(const f32x4*)(lnb + c); } }
#pragma unroll
        for (int ai = 0; ai < 2; ++ai)
#pragma unroll
            for (int m = 0; m < 4; ++m) {
                const int row = u.pm * 256 + ai * 128 + wr * 64 + m * 16 + fr;
                bf16_t* yr = Y + (size_t)row * DM;
                f32x2 st = {0.f, 0.f};
                if (!FIRST) st = *(const f32x2*)(stats + (size_t)row * 2);
#pragma unroll
                for (int bj = 0; bj < 2; ++bj) {
                    const int c = col0 + bj * 128;
                    f32x4 x0, x1;
                    if (FIRST) { const float* xr = row < TC ? xc + (size_t)row * DM : xl + (size_t)(row - TC) * DM; x0 = *(const f32x4*)(xr + c); x1 = *(const f32x4*)(xr + c + 4); }
                    else { up8(*(const u32x4*)(yr + c), x0, x1);
                        x0 = (x0 - st[0]) * st[1] * lg[bj][0] + lb[bj][0];
                        x1 = (x1 - st[0]) * st[1] * lg[bj][1] + lb[bj][1]; }
                    f32x4 a0 = acc[ai][bj][m][0], a1 = acc[ai][bj][m][1];
                    if (add) { a0 += slab_get(sl, ai, bj, m, 0, wid, lane); a1 += slab_get(sl, ai, bj, m, 1, wid, lane); }
                    *(u32x4*)(yr + c) = pk8(ALPHA * x0 + gt[bj][0] * a0, ALPHA * x1 + gt[bj][1] * a1);
                }
            }
    }
};

struct EpiEvenIn {
    static constexpr bool IDEMP = false;
    bf16_t* Q; bf16_t* P; bf16_t* Kc; bf16_t* VTc; bf16_t* Kl; bf16_t* VTl; float* outk; float* outv;
    const float* qg; const float* kg; const float* rope; int e;
    DI void operator()(AccRef acc, const pg8::Unit& u, int wr, int wc, int fr, int fq) const {
        const int pn = u.pn;
        if (pn >= 3) {
#pragma unroll
            for (int ai = 0; ai < 2; ++ai)
#pragma unroll
                for (int m = 0; m < 4; ++m) {
                    const int row = u.pm * 256 + ai * 128 + wr * 64 + m * 16 + fr;
                    bf16_t* pr = P + (size_t)row * 512 + (pn - 3) * 256 + wc * 32 + 8 * fq;
#pragma unroll
                    for (int bj = 0; bj < 2; ++bj)
#pragma unroll
                        for (int n = 0; n < 2; ++n) *(u32x2*)(pr + bj * 128 + n * 4) = pk4(acc[ai][bj][m][n]);
                }
            return;
        }
        const bool is_v = (pn == 2 && wc >= 2);
        const float* gw = pn < 2 ? qg : kg;
        f32x4 gh[2][2];
#pragma unroll
        for (int bj = 0; bj < 2; ++bj)
#pragma unroll
            for (int n = 0; n < 2; ++n) gh[bj][n] = *(const f32x4*)(gw + 32 * bj + 8 * fq + 4 * n);
#pragma unroll
        for (int ai = 0; ai < 2; ++ai)
#pragma unroll
            for (int m = 0; m < 4; ++m) {
                const int row = u.pm * 256 + ai * 128 + wr * 64 + m * 16 + fr;
                const bool latent = row >= TC;
                const int tpos = (row - TC) & 2047, b = (row - TC) >> 11;
                f32x4 v[2][2];
#pragma unroll
                for (int bj = 0; bj < 2; ++bj)
#pragma unroll
                    for (int n = 0; n < 2; ++n) v[bj][n] = acc[ai][bj][m][n];
                if (!is_v) {
                    float ss = 0.f;
#pragma unroll
                    for (int bj = 0; bj < 2; ++bj)
#pragma unroll
                        for (int n = 0; n < 2; ++n)
#pragma unroll
                            for (int j = 0; j < 4; ++j) ss += v[bj][n][j] * v[bj][n][j];
                    ss += __shfl_xor(ss, 16); ss += __shfl_xor(ss, 32);
                    const float rs = rsqrtf(ss * (1.0f / 64.0f) + RMS_EPS);
#pragma unroll
                    for (int bj = 0; bj < 2; ++bj)
#pragma unroll
                        for (int n = 0; n < 2; ++n) {
                            const int d = 32 * bj + 8 * fq + 4 * n;
                            v[bj][n] = v[bj][n] * rs * gh[bj][n];
                            if (latent) {
                                const f32x4 cs = *(const f32x4*)(rope + ((size_t)tpos * 32 + (d >> 1)) * 2);
                                const float x0 = v[bj][n][0], x1 = v[bj][n][1], x2 = v[bj][n][2], x3 = v[bj][n][3];
                                v[bj][n][0] = x0 * cs[0] - x1 * cs[1]; v[bj][n][1] = x0 * cs[1] + x1 * cs[0];
                                v[bj][n][2] = x2 * cs[2] - x3 * cs[3]; v[bj][n][3] = x2 * cs[3] + x3 * cs[2];
                            }
                        }
                }
                if (pn < 2) {
                    bf16_t* qr = Q + (size_t)row * 512 + (pn * 4 + wc) * 64 + 8 * fq;
#pragma unroll
                    for (int bj = 0; bj < 2; ++bj)
#pragma unroll
                        for (int n = 0; n < 2; ++n) *(u32x2*)(qr + 32 * bj + 4 * n) = pk4(v[bj][n] * QSCALE);
                } else if (!is_v) {
                    const int h = wc;
                    if (!latent) {
                        const int bb = row >> 8, t = row & 255;
                        float* ok = outk + ((size_t)(bb * 2 + e) * 256 + t) * 128 + h * 64 + 8 * fq;
                        bf16_t* kr = Kc + (size_t)row * 128 + h * 64 + 8 * fq;
#pragma unroll
                        for (int bj = 0; bj < 2; ++bj)
#pragma unroll
                            for (int n = 0; n < 2; ++n) { *(f32x4*)(ok + 32 * bj + 4 * n) = v[bj][n]; *(u32x2*)(kr + 32 * bj + 4 * n) = pk4(v[bj][n]); }
                    } else {
                        bf16_t* kr = Kl + ((size_t)b * 2304 + tpos) * 128 + h * 64 + 8 * fq;
#pragma unroll
                        for (int bj = 0; bj < 2; ++bj)
#pragma unroll
                            for (int n = 0; n < 2; ++n) *(u32x2*)(kr + 32 * bj + 4 * n) = pk4(v[bj][n]);
                    }
                } else {
                    const int h = wc - 2;
                    if (!latent) {
                        const int bb = row >> 8, t = row & 255;
                        float* ov = outv + ((size_t)(bb * 2 + e) * 256 + t) * 128 + h * 64 + 8 * fq;
                        bf16_t* vr = VTc + ((size_t)(bb * 2 + h) * 64 + 8 * fq) * 256 + t;
#pragma unroll
                        for (int bj = 0; bj < 2; ++bj)
#pragma unroll
                            for (int n = 0; n < 2; ++n) {
                                *(f32x4*)(ov + 32 * bj + 4 * n) = v[bj][n];
                                const u32x2 pv = pk4(v[bj][n]);
                                bf16_t* vp = vr + (size_t)(32 * bj + 4 * n) * 256;
                                vp[0] = (bf16_t)(pv.x & 0xffff); vp[256] = (bf16_t)(pv.x >> 16); vp[512] = (bf16_t)(pv.y & 0xffff); vp[768] = (bf16_t)(pv.y >> 16);
                            }
                    } else {
                        bf16_t* vr = VTl + ((size_t)(b * 2 + h) * 64 + 8 * fq) * 2304 + tpos;
#pragma unroll
                        for (int bj = 0; bj < 2; ++bj)
#pragma unroll
                            for (int n = 0; n < 2; ++n) {
                                const u32x2 pv = pk4(v[bj][n]);
                                bf16_t* vp = vr + (size_t)(32 * bj + 4 * n) * 2304;
                                vp[0] = (bf16_t)(pv.x & 0xffff); vp[2304] = (bf16_t)(pv.x >> 16); vp[4608] = (bf16_t)(pv.y & 0xffff); vp[6912] = (bf16_t)(pv.y >> 16);
                            }
                    }
                }
                __builtin_amdgcn_sched_barrier(0);
            }
    }
};

struct EpiOddIn {
    static constexpr bool IDEMP = false;
    bf16_t* HC; bf16_t* BG; bf16_t* XTc; bf16_t* XTl;
    DI void operator()(AccRef acc, const pg8::Unit& u, int wr, int wc, int fr, int fq) const {
        const int pn = u.pn;
#pragma unroll
        for (int ai = 0; ai < 2; ++ai)
#pragma unroll
            for (int m = 0; m < 4; ++m) {
                const int row = u.pm * 256 + ai * 128 + wr * 64 + m * 16 + fr;
                if (pn < 6) {
                    bf16_t* hr = HC + (size_t)row * 768 + pn * 128 + wc * 32 + 8 * fq;
#pragma unroll
                    for (int n = 0; n < 2; ++n) *(u32x2*)(hr + 4 * n) = pk4(acc[ai][0][m][n] * acc[ai][1][m][n]);
                } else if (pn < 9) {
                    bf16_t* br = BG + (size_t)row * 768 + (pn - 6) * 256 + wc * 32 + 8 * fq;
#pragma unroll
                    for (int bj = 0; bj < 2; ++bj)
#pragma unroll
                        for (int n = 0; n < 2; ++n) *(u32x2*)(br + bj * 128 + n * 4) = pk4(acc[ai][bj][m][n]);
                } else {
                    const int part = pn - 9;
                    bf16_t* xr; size_t cs;
                    if (row < TC) { const int bb = row >> 8, t = row & 255; cs = 512; xr = XTc + (size_t)bb * 256 * 512 + part * 256 + t; }
                    else { const int b = (row - TC) >> 11, t = (row - TC) & 2047; cs = 4096; xr = XTl + (size_t)b * 256 * 4096 + part * 2048 + t; }
#pragma unroll
                    for (int bj = 0; bj < 2; ++bj)
#pragma unroll
                        for (int n = 0; n < 2; ++n) {
                            const u32x2 pv = pk4(acc[ai][bj][m][n]);
                            bf16_t* xp = xr + (size_t)(bj * 128 + wc * 32 + n * 4 + 8 * fq) * cs;
                            xp[0] = (bf16_t)(pv.x & 0xffff); xp[cs] = (bf16_t)(pv.x >> 16); xp[2 * cs] = (bf16_t)(pv.y & 0xffff); xp[3 * cs] = (bf16_t)(pv.y >> 16);
                        }
                }
            }
    }
};

DI f32x4 silu_mul(f32x4 z, f32x4 g) {
    f32x4 y;
#pragma unroll
    for (int j = 0; j < 4; ++j) y[j] = z[j] * __builtin_amdgcn_rcpf(1.0f + __builtin_amdgcn_exp2f(-1.4426950408889634f * z[j])) * g[j];
    return y;
}
struct EpiUpConv {
    static constexpr bool IDEMP = true;
    bf16_t* Y; float* edge; const float* cw; const float* cb; LAS float* halo;
    DI void operator()(AccRef acc, const pg8::Unit& u, int wr, int wc, int fr, int fq) const {
        const int lane = fr + 16 * fq, chl = wc * 32 + 8 * fq, ch0 = u.pn * 128 + chl;
        f32x4 w0h[2], w1h[2], w2h[2], bbh[2];
#pragma unroll
        for (int n = 0; n < 2; ++n) { w0h[n] = *(const f32x4*)(cw + ch0 + 4 * n); w1h[n] = *(const f32x4*)(cw + DFF + ch0 + 4 * n); w2h[n] = *(const f32x4*)(cw + 2 * DFF + ch0 + 4 * n); bbh[n] = *(const f32x4*)(cb + ch0 + 4 * n); }
#pragma unroll
        for (int ai = 0; ai < 2; ++ai)
#pragma unroll
            for (int n = 0; n < 2; ++n) {
                if (fr == 0) *(LAS f32x4*)(halo + ((ai * 2 + wr) * 2 + 0) * 128 + chl + 4 * n) = acc[ai][0][0][n];
                if (fr == 15) *(LAS f32x4*)(halo + ((ai * 2 + wr) * 2 + 1) * 128 + chl + 4 * n) = acc[ai][0][3][n];
            }
        asm volatile("s_waitcnt lgkmcnt(0)" ::: "memory");
        __builtin_amdgcn_s_barrier(); __builtin_amdgcn_s_barrier();
        asm volatile("" ::: "memory");
        const int lprev = (lane & 48) | ((fr + 15) & 15), lnext = (lane & 48) | ((fr + 1) & 15);
        float* eg = edge + (size_t)u.pm * 6 * DFF + ch0;
#pragma unroll
        for (int n = 0; n < 2; ++n) {
            const f32x4 w0 = w0h[n], w1 = w1h[n], w2 = w2h[n], bb = bbh[n];
#pragma unroll
            for (int ai = 0; ai < 2; ++ai) {
                const int blk = ai * 2 + wr;
                f32x4 uph = {0.f, 0.f, 0.f, 0.f}, dnh = {0.f, 0.f, 0.f, 0.f};
                if (blk > 0) uph = *(const LAS f32x4*)(halo + ((blk - 1) * 2 + 1) * 128 + chl + 4 * n);
                if (blk < 3) dnh = *(const LAS f32x4*)(halo + ((blk + 1) * 2 + 0) * 128 + chl + 4 * n);
                f32x4 rr[4], rl[4];
#pragma unroll
                for (int m = 0; m < 4; ++m)
#pragma unroll
                    for (int j = 0; j < 4; ++j) { rr[m][j] = __shfl(acc[ai][0][m][n][j], lprev); rl[m][j] = __shfl(acc[ai][0][m][n][j], lnext); }
#pragma unroll
                for (int m = 0; m < 4; ++m) {
                    const f32x4 prev = fr > 0 ? rr[m] : (m > 0 ? rr[m > 0 ? m - 1 : 0] : uph);
                    const f32x4 next = fr < 15 ? rl[m] : (m < 3 ? rl[m < 3 ? m + 1 : 3] : dnh);
                    const f32x4 a = acc[ai][0][m][n], g = acc[ai][1][m][n];
                    const f32x4 z = bb + w0 * prev + w1 * a + w2 * next;
                    const int row = u.pm * 256 + ai * 128 + wr * 64 + m * 16 + fr;
                    *(u32x2*)(Y + (size_t)row * DFF + ch0 + 4 * n) = pk4(silu_mul(z, g));
                    if (ai == 0 && m == 0 && wr == 0 && fr == 0) { *(f32x4*)(eg + 4 * n) = z; *(f32x4*)(eg + DFF + 4 * n) = g; *(f32x4*)(eg + 2 * DFF + 4 * n) = a; }
                    if (ai == 1 && m == 3 && wr == 1 && fr == 15) { *(f32x4*)(eg + 3 * DFF + 4 * n) = z; *(f32x4*)(eg + 4 * DFF + 4 * n) = g; *(f32x4*)(eg + 5 * DFF + 4 * n) = a; }
                }
            }
        }
    }
};

struct EpiFourier {
    static constexpr bool IDEMP = false;
    bf16_t* mb;
    float* slabs; unsigned* flags;
    DI void operator()(AccRef acc, const pg8::Unit& u, int wr, int wc, int fr, int fq) const {
        const int wid = wr * 4 + wc, lane = fr + 16 * fq;
        if (u.role == 1) { slab_publish(slabs + (size_t)u.slab * 65536, flags + u.slab * 8, acc, wid, lane); return; }
        const bool add = u.role == 2;
        if (add) slab_wait(flags + u.slab * 8, wid);
        const float* sl = slabs + (size_t)u.slab * 65536;
#pragma unroll
        for (int ai = 0; ai < 2; ++ai)
#pragma unroll
            for (int m = 0; m < 4; ++m) {
                const int row = u.pm * 256 + ai * 128 + wr * 64 + m * 16 + fr;
                bf16_t* mr = mb + (size_t)row * DM + wc * 32 + 4 * fq;
                f32x4 sv[2][2];
                if (add) {
#pragma unroll
                    for (int bj = 0; bj < 2; ++bj)
#pragma unroll
                        for (int n = 0; n < 2; ++n) sv[bj][n] = slab_get(sl, ai, bj, m, n, wid, lane);
                }
#pragma unroll
                for (int bj = 0; bj < 2; ++bj)
#pragma unroll
                    for (int n = 0; n < 2; ++n) {
                        f32x4 a = acc[ai][bj][m][n];
                        if (add) a += sv[bj][n];
                        *(u32x2*)(mr + bj * 128 + n * 16) = pk4(a);
                    }
            }
    }
};

struct TrJob { const float* src; bf16_t* dst; int ld, Kd, k0, n0, type; };
DI int tr_srccol(int type, int np) {
    const int n = lpos(np);
    if (type == 0) return n < 768 ? ((n & ~255) + ((n >> 5) & 3) * 64 + ((n >> 7) & 1) * 32 + (n & 31)) : n;
    if (type == 1) return n < 1536 ? ((((n >> 7) & 1) ? 1536 : 0) + (n >> 8) * 128 + (n & 127)) : (768 + (n - 1536));
    if (type == 3) return (((n >> 7) & 1) ? 2816 : 0) + (n >> 8) * 128 + (n & 127);
    return n;
}

DI void convert_weights(const PRef p, const int tid, const int cc, const int GG, int l, LAS unsigned char* lds, unsigned char* wbase) {
    LAS float* t = (LAS float*)lds;
    const int G = GG, c = cc;
    const bool even = (l & 1) == 0; const int eo = l >> 1;
    bf16_t* WIN = (bf16_t*)(wbase); bf16_t* WOUT = (bf16_t*)(wbase + (OFF_WOUT - OFF_W)); bf16_t* WUP = (bf16_t*)(wbase + (OFF_WUP - OFF_W)); bf16_t* WDN = (bf16_t*)(wbase + (OFF_WDN - OFF_W));
    const float* w_out = p.in(16) + (size_t)l * 1024 * 1024;
    const float* w_up = p.in(17) + (size_t)l * 1024 * 5632;
    const float* w_dn = p.in(20) + (size_t)l * 2816 * 1024;
    const int n_in = even ? 20 * 16 : 36 * 16;
    const int n_out = even ? 16 * 8 : 16 * 16;
    const int n_up = 88 * 16, n_dn = 16 * 44;
    const int total = n_in + n_out + n_up + n_dn;
    for (int j0 = c; j0 < total; j0 += 4 * G) {
        TrJob jb[4];
#pragma unroll
        for (int qi = 0; qi < 4; ++qi) {
            int q = j0 + qi * G; TrJob J; J.type = -1; J.src = nullptr; J.dst = nullptr; J.ld = 0; J.Kd = 0; J.k0 = 0; J.n0 = 0;
            if (q < total) {
                if (q < n_in) { J.n0 = (q >> 4) * 64; J.k0 = (q & 15) * 64; J.dst = WIN; J.Kd = 1024;
                    if (even) { J.src = p.in(8) + (size_t)eo * 1024 * 1280; J.ld = 1280; J.type = 0; } else { J.src = p.in(13) + (size_t)eo * 1024 * 2560; J.ld = 2560; J.type = 1; } }
                else if ((q -= n_in) < n_out) { J.n0 = (even ? (q >> 3) : (q >> 4)) * 64; J.k0 = (even ? (q & 7) : (q & 15)) * 64; J.src = w_out; J.ld = 1024; J.dst = WOUT; J.Kd = 1024; J.type = 2; }
                else if ((q -= n_out) < n_up) { J.n0 = (q >> 4) * 64; J.k0 = (q & 15) * 64; J.src = w_up; J.ld = 5632; J.dst = WUP; J.Kd = 1024; J.type = 3; }
                else { q -= n_up; J.n0 = (q / 44) * 64; J.k0 = (q % 44) * 64; J.src = w_dn; J.ld = 1024; J.dst = WDN; J.Kd = 2816; J.type = 2; }
            }
            jb[qi] = J;
        }
        float rg[4][8];
        { const int nn = tid & 63, kk = tid >> 6;
#pragma unroll
          for (int qi = 0; qi < 4; ++qi) if (jb[qi].type >= 0) { const int sc = tr_srccol(jb[qi].type, jb[qi].n0 + nn);
#pragma unroll
              for (int i = 0; i < 8; ++i) rg[qi][i] = jb[qi].src[(size_t)(jb[qi].k0 + kk + 8 * i) * jb[qi].ld + sc]; }
#pragma unroll
          for (int qi = 0; qi < 4; ++qi) if (jb[qi].type >= 0) {
#pragma unroll
              for (int i = 0; i < 8; ++i) t[qi * 4160 + (kk + 8 * i) * 65 + nn] = rg[qi][i]; } }
        __syncthreads();
        { const int kp = tid & 31, nr = tid >> 5;
#pragma unroll
          for (int qi = 0; qi < 4; ++qi) if (jb[qi].type >= 0) {
#pragma unroll
              for (int i = 0; i < 4; ++i) { const int n = nr + 16 * i; const float a = t[qi * 4160 + (2 * kp) * 65 + n], b = t[qi * 4160 + (2 * kp + 1) * 65 + n];
                  *(unsigned*)(jb[qi].dst + (size_t)(jb[qi].n0 + n) * jb[qi].Kd + jb[qi].k0 + 2 * kp) = pk(a, b); } } }
        __syncthreads();
    }
    if (even) {
        const float* wp = p.in(11) + (size_t)eo * 4 * 128 * 128; const float* sc = p.in(12) + (size_t)eo * 512;
        for (int uu = c; uu < 256; uu += G) {
            const int g = uu >> 6, c0 = (uu & 63) * 2;
            __syncthreads();
            if (tid < 256) { const int cc = tid >> 7, d = tid & 127; t[tid] = wp[((size_t)g * 128 + c0 + cc) * 128 + d] * sc[g * 128 + d]; }
            __syncthreads();
            float a00 = 0.f, a01 = 0.f, a10 = 0.f, a11 = 0.f;
            const float* wo = w_out + (size_t)(512 + g * 128) * 1024;
#pragma unroll 8
            for (int d = 0; d < 128; ++d) {
                const float w0 = wo[(size_t)d * 1024 + tid], w1 = wo[(size_t)d * 1024 + 512 + tid];
                const float k0 = t[d], k1 = t[128 + d];
                a00 += k0 * w0; a01 += k1 * w0; a10 += k0 * w1; a11 += k1 * w1;
            }
            *(unsigned*)(WOUT + (size_t)ppos(tid) * 1024 + 512 + g * 128 + c0) = pk(a00, a01);
            *(unsigned*)(WOUT + (size_t)ppos(tid + 512) * 1024 + 512 + g * 128 + c0) = pk(a10, a11);
        }
    } else {
        const float* wf = p.in(13) + (size_t)eo * 1024 * 2560 + 2304;
        __syncthreads();
        if (tid < 64) { float s, co; sincospif((float)tid * (1.0f / 32.0f), &s, &co); t[512 + tid] = co; t[576 + tid] = s; }
        for (int uu = c; uu < 512; uu += G) {
            __syncthreads();
            t[tid] = wf[(size_t)(2 * uu + (tid >> 8)) * 2560 + (tid & 255)];
            __syncthreads();
            const int part = tid >> 8, ch = tid & 255, g = ch >> 6, mm = ch & 63;
            float a0 = 0.f, a1 = 0.f;
            for (int cc = 0; cc < 64; ++cc) { const float tw = t[512 + part * 64 + ((mm * cc) & 63)]; a0 += tw * t[g * 64 + cc]; a1 += tw * t[256 + g * 64 + cc]; }
            *(unsigned*)(WIN + (size_t)(2304 + ppos(tid)) * 1024 + 2 * uu) = pk(a0, a1);
        }
        __syncthreads();
    }
}

DI void prep_a(const PRef p, const Ctx X, LAS unsigned char* lds) {
    const int G = X.G, c = X.c, tid = X.tid, wid = tid >> 6, lane = tid & 63;
    {
        LAS float* sc = (LAS float*)lds;
        LAS float* part = sc + 9 * 1024;
        for (int i = tid; i < 9 * 1024; i += 512) { const int j = i >> 10, k = i & 1023; const float x = j == 0 ? p.in(5)[k] : p.in(4)[(size_t)(j - 1) * 1024 + k]; sc[i] = x / (1.0f + __expf(-x)); }
        __syncthreads();
        float* ada = (float*)(p.ws() + OFF_ADA);
        for (int uu = c; uu < 192; uu += G) {
            const int l = uu / 48, cb = uu % 48;
            const float* w = p.in(6) + (size_t)l * 1024 * 6144 + cb * 128 + 2 * lane;
            float a0[9], a1[9];
#pragma unroll
            for (int j = 0; j < 9; ++j) { a0[j] = 0.f; a1[j] = 0.f; }
            const int k0 = wid * 128;
#pragma unroll 16
            for (int k = 0; k < 128; ++k) { const f32x2 wv = *(const f32x2*)(w + (size_t)(k0 + k) * 6144);
#pragma unroll
                for (int j = 0; j < 9; ++j) { const float sv = sc[j * 1024 + k0 + k]; a0[j] += sv * wv[0]; a1[j] += sv * wv[1]; } }
#pragma unroll
            for (int j = 0; j < 9; ++j) *(LAS f32x2*)(part + (wid * 9 + j) * 128 + 2 * lane) = (f32x2){a0[j], a1[j]};
            __syncthreads();
            for (int i = tid; i < 9 * 128; i += 512) { const int j = i >> 7, cc = i & 127; float sm = 0.f;
#pragma unroll
                for (int w8 = 0; w8 < 8; ++w8) sm += part[(w8 * 9 + j) * 128 + cc];
                ada[((size_t)l * 9 + j) * 6144 + cb * 128 + cc] = sm + p.in(7)[(size_t)l * 6144 + cb * 128 + cc]; }
            __syncthreads();
        }
    }
    convert_weights(p, tid, c, G, 0, lds, p.ws() + OFF_W);
    const int gt = c * 512 + tid, GT = G * 512;
    {
        bf16_t* D = (bf16_t*)(p.ws() + OFF_DFT);
        const float s = 1.0f / 362.03867196751236f;
        for (int i = gt; i < 2048 * 1024; i += GT) { const int k = i >> 10, t2 = (i & 1023) * 2;
            float s0, c0, s1, c1; sincospif((float)((k * t2) & 2047) * (1.0f / 1024.0f), &s0, &c0); sincospif((float)((k * (t2 + 1)) & 2047) * (1.0f / 1024.0f), &s1, &c1);
            *(unsigned*)(D + (size_t)k * 4096 + t2) = pk(c0 * s, c1 * s); *(unsigned*)(D + (size_t)k * 4096 + 2048 + t2) = pk(-s0 * s, -s1 * s); }
        bf16_t* D2 = (bf16_t*)(p.ws() + OFF_DFT256);
        const float s2 = 1.0f / 128.0f;
        for (int i = gt; i < 256 * 128; i += GT) { const int k = i >> 7, t2 = (i & 127) * 2;
            float s0, c0, s1, c1; sincospif((float)((k * t2) & 255) * (1.0f / 128.0f), &s0, &c0); sincospif((float)((k * (t2 + 1)) & 255) * (1.0f / 128.0f), &s1, &c1);
            *(unsigned*)(D2 + (size_t)k * 512 + t2) = pk(c0 * s2, c1 * s2); *(unsigned*)(D2 + (size_t)k * 512 + 256 + t2) = pk(-s0 * s2, -s1 * s2); }
    }
    {
        float* R = (float*)(p.ws() + OFF_ROPE);
        for (int i = gt; i < 2048 * 32; i += GT) { const int t = i >> 5, f = i & 31; const float pos = (float)(f < 16 ? (t >> 6) : (t & 63));
            const float inv = 1.0f / powf(10000.0f, (float)(f & 15) * (1.0f / 16.0f)); const float ang = pos * inv; R[2 * i] = cosf(ang); R[2 * i + 1] = sinf(ang); }
    }
    {
        for (int i = gt; i < 8 * 2 * 256 * 128; i += GT) {
            const int col = i & 127, s = (i >> 7) & 255, e = (i >> 15) & 1, b = i >> 16;
            bf16_t* Kl = (bf16_t*)(p.ws() + OFF_KVL + (size_t)e * KVL_SZ); bf16_t* VTl = (bf16_t*)(p.ws() + OFF_KVL + (size_t)(2 + e) * KVL_SZ);
            const unsigned kv = pk(p.in(2)[i], 0.f), vv = pk(p.in(3)[i], 0.f);
            Kl[((size_t)b * 2304 + 2048 + s) * 128 + col] = (bf16_t)(kv & 0xffff);
            const int h = col >> 6, d = col & 63;
            VTl[((size_t)(b * 2 + h) * 64 + d) * 2304 + 2048 + s] = (bf16_t)(vv & 0xffff);
        }
    }
}

template <int MODE>
DI void ln_pass(const Ctx X, const float* srcc, const float* srcl, const bf16_t* Y, float* stats, float* xout, bf16_t* udst, const float* lng, const float* lnb, const float* adash, const float* adasc) {
    const int lane = X.tid & 63, GWV = X.G * 8, RPW = (T + GWV - 1) / GWV;
    const int gw = (X.c * 8 + (X.tid >> 6)) * RPW, rend = gw + RPW < T ? gw + RPW : T;
    const int cb = lane * 8;
    f32x4 nf[4]; u32x4 nb[2];
#define LN_LOAD(R) do { const int r_ = (R); if (MODE == 0) { const float* src = r_ < TC ? srcc + (size_t)r_ * DM : srcl + (size_t)(r_ - TC) * DM; \
            nf[0] = *(const f32x4*)(src + cb); nf[1] = *(const f32x4*)(src + cb + 4); nf[2] = *(const f32x4*)(src + cb + 512); nf[3] = *(const f32x4*)(src + cb + 516); } \
        else { nb[0] = *(const u32x4*)(Y + (size_t)r_ * DM + cb); nb[1] = *(const u32x4*)(Y + (size_t)r_ * DM + cb + 512); } } while (0)
    f32x4 hg[4], hb[4];
    if (MODE != 0) {
#pragma unroll
        for (int i = 0; i < 4; ++i) { const int c = cb + (i >> 1) * 512 + (i & 1) * 4; hg[i] = *(const f32x4*)(lng + c); hb[i] = *(const f32x4*)(lnb + c); }
    }
    if (gw < T) LN_LOAD(gw);
    int cdh = -1; f32x4 hs[4], hh[4];
    for (int row = gw; row < rend; ++row) {
        f32x4 v[4];
        if (MODE == 0) {
#pragma unroll
            for (int i = 0; i < 4; ++i) v[i] = nf[i];
        } else { up8(nb[0], v[0], v[1]); up8(nb[1], v[2], v[3]); }
        if (row + 1 < rend) LN_LOAD(row + 1);
        if (MODE != 0) {
            float s1 = 0.f, s2 = 0.f;
#pragma unroll
            for (int i = 0; i < 4; ++i)
#pragma unroll
                for (int j = 0; j < 4; ++j) { s1 += v[i][j]; s2 += v[i][j] * v[i][j]; }
#pragma unroll
            for (int o = 32; o > 0; o >>= 1) { s1 += __shfl_xor(s1, o); s2 += __shfl_xor(s2, o); }
            const float mu = s1 * (1.0f / 1024.0f);
            const float rstd = rsqrtf(fmaxf(s2 * (1.0f / 1024.0f) - mu * mu, 0.f) + LN_EPS);
            if (MODE == 1 && lane == 0) *(f32x2*)(stats + (size_t)row * 2) = (f32x2){mu, rstd};
#pragma unroll
            for (int i = 0; i < 4; ++i) { const int c = cb + (i >> 1) * 512 + (i & 1) * 4;
                v[i] = (v[i] - mu) * rstd * hg[i] + hb[i];
                if (MODE == 2) *(f32x4*)(xout + (size_t)row * DM + c) = v[i]; }
        }
        if (MODE != 2) {
            float s1 = 0.f, s2 = 0.f;
#pragma unroll
            for (int i = 0; i < 4; ++i)
#pragma unroll
                for (int j = 0; j < 4; ++j) { s1 += v[i][j]; s2 += v[i][j] * v[i][j]; }
#pragma unroll
            for (int o = 32; o > 0; o >>= 1) { s1 += __shfl_xor(s1, o); s2 += __shfl_xor(s2, o); }
            const float mu = s1 * (1.0f / 1024.0f);
            const float rstd = rsqrtf(fmaxf(s2 * (1.0f / 1024.0f) - mu * mu, 0.f) + LN_EPS);
            const int cd = cond_of(row);
            if (cd != cdh) { cdh = cd;
#pragma unroll
                for (int i = 0; i < 4; ++i) { const int c = cb + (i >> 1) * 512 + (i & 1) * 4; hs[i] = 1.0f + *(const f32x4*)(adasc + cd * 6144 + c); hh[i] = *(const f32x4*)(adash + cd * 6144 + c); } }
            f32x4 o4[4];
#pragma unroll
            for (int i = 0; i < 4; ++i) o4[i] = (v[i] - mu) * rstd * hs[i] + hh[i];
            *(u32x4*)(udst + (size_t)row * DM + cb) = pk8(o4[0], o4[1]);
            *(u32x4*)(udst + (size_t)row * DM + cb + 512) = pk8(o4[2], o4[3]);
        }
    }
#undef LN_LOAD
}

constexpr int KROW = 144, VROW = 136, KBUF = 64 * KROW, VBUF = 64 * VROW, ABUF = KBUF + VBUF;
template <int VSTR>
DI void attn_tile(LAS unsigned char* kb_, LAS unsigned char* vb_, const int r, const int h, const bf16x8 (&qf)[4], f32x16 (&o)[2], float& mrun, float& lsum) {
        bf16x8 kf[2][4];
#pragma unroll
        for (int kb = 0; kb < 2; ++kb)
#pragma unroll
            for (int ks = 0; ks < 4; ++ks) kf[kb][ks] = *(const LAS bf16x8*)(kb_ + (kb * 32 + r) * KROW + (16 * ks + 8 * h) * 2);
        __builtin_amdgcn_sched_barrier(0);
        f32x16 s[2];
#pragma unroll
        for (int kb = 0; kb < 2; ++kb) {
#pragma unroll
            for (int i = 0; i < 16; ++i) s[kb][i] = 0.f;
#pragma unroll
            for (int ks = 0; ks < 4; ++ks) s[kb] = __builtin_amdgcn_mfma_f32_32x32x16_bf16(kf[kb][ks], qf[ks], s[kb], 0, 0, 0);
        }
        u32x2 vf[2][2][2][2];
#pragma unroll
        for (int kb = 0; kb < 2; ++kb)
#pragma unroll
            for (int st = 0; st < 2; ++st)
#pragma unroll
                for (int db = 0; db < 2; ++db) {
                    const LAS unsigned char* va = vb_ + (db * 32 + r) * VSTR + (kb * 32 + 16 * st + 4 * h) * 2;
                    vf[kb][st][db][0] = *(const LAS u32x2*)va; vf[kb][st][db][1] = *(const LAS u32x2*)(va + 16);
                }
        __builtin_amdgcn_sched_barrier(0);
        float mx = s[0][0];
#pragma unroll
        for (int i = 1; i < 16; ++i) mx = fmaxf(mx, s[0][i]);
#pragma unroll
        for (int i = 0; i < 16; ++i) mx = fmaxf(mx, s[1][i]);
        mx = fmaxf(mx, __shfl_xor(mx, 32));
        if (__builtin_amdgcn_ballot_w64(mx > mrun) != 0ull) {
            const float mnew = fmaxf(mrun, mx);
            const float al = __builtin_amdgcn_exp2f(mrun - mnew);
            mrun = mnew; lsum *= al;
#pragma unroll
            for (int i = 0; i < 16; ++i) { o[0][i] *= al; o[1][i] *= al; }
        }
        float ps = 0.f;
#pragma unroll
        for (int kb = 0; kb < 2; ++kb)
#pragma unroll
            for (int i = 0; i < 16; ++i) { s[kb][i] = __builtin_amdgcn_exp2f(s[kb][i] - mrun); ps += s[kb][i]; }
        lsum += ps;
        bf16x8 pf[2][2];
#pragma unroll
        for (int kb = 0; kb < 2; ++kb)
#pragma unroll
            for (int st = 0; st < 2; ++st) {
                u32x4 pp;
                pp.x = pk(s[kb][8 * st + 0], s[kb][8 * st + 1]); pp.y = pk(s[kb][8 * st + 2], s[kb][8 * st + 3]);
                pp.z = pk(s[kb][8 * st + 4], s[kb][8 * st + 5]); pp.w = pk(s[kb][8 * st + 6], s[kb][8 * st + 7]);
                pf[kb][st] = __builtin_bit_cast(bf16x8, pp);
            }
        __builtin_amdgcn_sched_barrier(0);
#pragma unroll
        for (int kb = 0; kb < 2; ++kb)
#pragma unroll
            for (int st = 0; st < 2; ++st)
#pragma unroll
                for (int db = 0; db < 2; ++db) {
                    const u32x4 vv = {vf[kb][st][db][0].x, vf[kb][st][db][0].y, vf[kb][st][db][1].x, vf[kb][st][db][1].y};
                    o[db] = __builtin_amdgcn_mfma_f32_32x32x16_bf16(__builtin_bit_cast(bf16x8, vv), pf[kb][st], o[db], 0, 0, 0);
                }
        __builtin_amdgcn_sched_barrier(0);
}

DI void attn_unit(const int tid, LAS unsigned char* lds, const bf16_t* Q, const bf16_t* Kb, const bf16_t* VTb, int Lk, bf16_t* Mo, int q0row, int kvh) {
    const int wid = tid >> 6, lane = tid & 63, r = lane & 31, h = lane >> 5;
    const int head = kvh * 4 + (wid & 3);
    const int qrow = q0row + (wid >> 2) * 32 + r;
    bf16x8 qf[4];
#pragma unroll
    for (int ks = 0; ks < 4; ++ks) qf[ks] = *(const bf16x8*)(Q + (size_t)qrow * 512 + head * 64 + 16 * ks + 8 * h);
    const int srow = tid >> 3, sch = tid & 7;
    const bf16_t* kg = Kb + (size_t)srow * 128 + sch * 8;
    const bf16_t* vg = VTb + (size_t)srow * Lk + sch * 8;
    const int nt = Lk >> 6;
    u32x4 kreg0 = *(const u32x4*)kg, vreg0 = *(const u32x4*)vg;
    u32x4 kreg1 = *(const u32x4*)(kg + (size_t)64 * 128), vreg1 = *(const u32x4*)(vg + 64);
    __syncthreads();
    *(LAS u32x4*)(lds + srow * KROW + sch * 16) = kreg0;
    *(LAS u32x2*)(lds + KBUF + srow * VROW + sch * 16) = (u32x2){vreg0.x, vreg0.y};
    *(LAS u32x2*)(lds + KBUF + srow * VROW + sch * 16 + 8) = (u32x2){vreg0.z, vreg0.w};
    __syncthreads();
    f32x16 o[2];
#pragma unroll
    for (int i = 0; i < 16; ++i) { o[0][i] = 0.f; o[1][i] = 0.f; }
    float mrun = -1e30f, lsum = 0.f;
#define ATT_STEP(T_, KCUR, VCUR, KNXT, VNXT) do { const int t = (T_); \
        LAS unsigned char* kb_ = lds + (t & 1) * ABUF; LAS unsigned char* vb_ = kb_ + KBUF; \
        if (t + 2 < nt) { KCUR = *(const u32x4*)(kg + (size_t)(t + 2) * 64 * 128); VCUR = *(const u32x4*)(vg + (t + 2) * 64); } \
        attn_tile<VROW>(kb_, vb_, r, h, qf, o, mrun, lsum); \
        if (t + 1 < nt) { LAS unsigned char* nb = lds + ((t + 1) & 1) * ABUF; \
            *(LAS u32x4*)(nb + srow * KROW + sch * 16) = KNXT; \
            *(LAS u32x2*)(nb + KBUF + srow * VROW + sch * 16) = (u32x2){VNXT.x, VNXT.y}; \
            *(LAS u32x2*)(nb + KBUF + srow * VROW + sch * 16 + 8) = (u32x2){VNXT.z, VNXT.w}; } \
        __syncthreads(); } while (0)
    for (int t2 = 0; t2 < nt; t2 += 2) {
        ATT_STEP(t2, kreg0, vreg0, kreg1, vreg1);
        ATT_STEP(t2 + 1, kreg1, vreg1, kreg0, vreg0);
    }
#undef ATT_STEP
    const float lt = lsum + __shfl_xor(lsum, 32);
    const float inv = 1.0f / lt;
    bf16_t* mo = Mo + (size_t)qrow * DM + head * 64 + 4 * h;
#pragma unroll
    for (int db = 0; db < 2; ++db)
#pragma unroll
        for (int g = 0; g < 4; ++g) {
            const f32x4 ov = {o[db][4 * g] * inv, o[db][4 * g + 1] * inv, o[db][4 * g + 2] * inv, o[db][4 * g + 3] * inv};
            *(u32x2*)(mo + db * 32 + g * 8) = pk4(ov);
        }
}

constexpr int CVS = 520, CKALL = 256 * KROW;
DI void attn_unit_ctx(const int tid, LAS unsigned char* lds, const bf16_t* Q, const bf16_t* Kb, const bf16_t* VTb, bf16_t* Mo, int q0row, int kvh) {
    const int wid = tid >> 6, lane = tid & 63, r = lane & 31, h = lane >> 5;
    const int head = kvh * 4 + (wid & 3);
    const int qrow = q0row + (wid >> 2) * 32 + r;
    bf16x8 qf[4];
#pragma unroll
    for (int ks = 0; ks < 4; ++ks) qf[ks] = *(const bf16x8*)(Q + (size_t)qrow * 512 + head * 64 + 16 * ks + 8 * h);
    const int srow = tid >> 3, sch = tid & 7;
    u32x4 kr[4], vr[4];
#pragma unroll
    for (int i = 0; i < 4; ++i) { kr[i] = *(const u32x4*)(Kb + (size_t)(srow + 64 * i) * 128 + sch * 8); vr[i] = *(const u32x4*)(VTb + (size_t)srow * 256 + (sch + 8 * i) * 8); }
    __syncthreads();
#pragma unroll
    for (int i = 0; i < 4; ++i) {
        *(LAS u32x4*)(lds + (srow + 64 * i) * KROW + sch * 16) = kr[i];
        LAS unsigned char* vp = lds + CKALL + srow * CVS + (sch + 8 * i) * 16;
        *(LAS u32x2*)vp = (u32x2){vr[i].x, vr[i].y}; *(LAS u32x2*)(vp + 8) = (u32x2){vr[i].z, vr[i].w};
    }
    __syncthreads();
    f32x16 o[2];
#pragma unroll
    for (int i = 0; i < 16; ++i) { o[0][i] = 0.f; o[1][i] = 0.f; }
    float mrun = -1e30f, lsum = 0.f;
#pragma unroll
    for (int t = 0; t < 4; ++t) attn_tile<CVS>(lds + t * 64 * KROW, lds + CKALL + t * 128, r, h, qf, o, mrun, lsum);
    const float lt = lsum + __shfl_xor(lsum, 32);
    const float inv = 1.0f / lt;
    bf16_t* mo = Mo + (size_t)qrow * DM + head * 64 + 4 * h;
#pragma unroll
    for (int db = 0; db < 2; ++db)
#pragma unroll
        for (int g = 0; g < 4; ++g) {
            const f32x4 ov = {o[db][4 * g] * inv, o[db][4 * g + 1] * inv, o[db][4 * g + 2] * inv, o[db][4 * g + 3] * inv};
            *(u32x2*)(mo + db * 32 + g * 8) = pk4(ov);
        }
}

template <int H>
DI void pool_block(const bf16_t* Pc, bf16_t* Mc, const int seq0, const int L, const int tl0) {
    unsigned v[32 + 2 * H];
#pragma unroll
    for (int i = 0; i < 32 + 2 * H; ++i) { const int j = tl0 - H + i; v[i] = (j >= 0 && j < L) ? *(const unsigned*)(Pc + (size_t)(seq0 + j) * 512) : 0u; }
    float s0 = 0.f, s1 = 0.f;
#pragma unroll
    for (int k = 0; k < 2 * H; ++k) { s0 += bflo(v[k]); s1 += bfhi(v[k]); }
#pragma unroll
    for (int i = 0; i < 32; ++i) {
        const int tl = tl0 + i;
        const int lo = tl - H > 0 ? tl - H : 0, hi = tl + H < L ? tl + H : L;
        const float ic = 1.0f / (float)(hi - lo);
        *(unsigned*)(Mc + (size_t)(seq0 + tl) * DM) = pk(s0 * ic - bflo(v[i + H]), s1 * ic - bfhi(v[i + H]));
        s0 += bflo(v[i + 2 * H]) - bflo(v[i]); s1 += bfhi(v[i + 2 * H]) - bfhi(v[i]);
    }
}

DI void mixer_even(const PRef p, const Ctx X, int e, LAS unsigned char* lds) {
    const int G = X.G, c = X.c, tid = X.tid;
    const bf16_t* Q = (const bf16_t*)(p.ws() + OFF_Q); const bf16_t* P = (const bf16_t*)(p.ws() + OFF_P);
    const bf16_t* Kc = (const bf16_t*)(p.ws() + OFF_KC); const bf16_t* VTc = (const bf16_t*)(p.ws() + OFF_VTC);
    const bf16_t* Kl = (const bf16_t*)(p.ws() + OFF_KVL + (size_t)e * KVL_SZ); const bf16_t* VTl = (const bf16_t*)(p.ws() + OFF_KVL + (size_t)(2 + e) * KVL_SZ);
    bf16_t* Mo = (bf16_t*)(p.ws() + OFF_R1);
    for (int u = c; u < 512; u += G) {
        const int pr = G == 256 ? 2 * (c & 7) + (u >> 8) : (u >> 5), qb = G == 256 ? (c >> 3) : (u & 31);
        const int b = pr >> 1, kvh = pr & 1;
        attn_unit(tid, lds, Q, Kl + (size_t)b * 2304 * 128 + kvh * 64, VTl + (size_t)(b * 2 + kvh) * 64 * 2304, 2304, Mo, TC + b * 2048 + qb * 64, kvh);
    }
    for (int u = c; u < 128; u += G) {
        const int bb = u >> 3, kvh = (u >> 2) & 1, qb = u & 3;
        attn_unit_ctx(tid, lds, Q, Kc + (size_t)bb * 256 * 128 + kvh * 64, VTc + (size_t)(bb * 2 + kvh) * 64 * 256, Mo, bb * 256 + qb * 64, kvh);
    }
    for (int u = G - 1 - c; u < 320; u += G) {
        const int row0 = u * 64 + (tid >> 8) * 32;
        const int seq0 = row0 < TC ? (row0 & ~255) : TC + ((row0 - TC) & ~2047);
        const int L = row0 < TC ? 256 : 2048;
        const int cp = tid & 255, grp = cp >> 6;
        const bf16_t* Pc = P + 2 * cp; bf16_t* Mc = Mo + 512 + 2 * cp;
        if (grp == 0) pool_block<1>(Pc, Mc, seq0, L, row0 - seq0);
        else if (grp == 1) pool_block<2>(Pc, Mc, seq0, L, row0 - seq0);
        else if (grp == 2) pool_block<4>(Pc, Mc, seq0, L, row0 - seq0);
        else pool_block<8>(Pc, Mc, seq0, L, row0 - seq0);
    }
}

DI void mixer_odd(const PRef p, const Ctx X, int o, LAS unsigned char* lds) {
    const int G = X.G, c = X.c, tid = X.tid;
    bf16_t* Mo = (bf16_t*)(p.ws() + OFF_R1);
    float* fsl = (float*)(p.ws() + OFF_R1 + 56 * MiB); unsigned* ffl = (unsigned*)(p.ws() + OFF_BAR + 16384 + 8192) + o * 1536;
    const int jstep = G == 256 ? 128 : G;
    for (int j = c; j < 144 && (G != 256 || c < 128); j += jstep) {
        pg8::Gemm g; pg8::OneUnit S; EpiFourier E; E.slabs = fsl; E.flags = ffl;
        if (j < 128) { const int prod = j < 64, base = j & 63, b = base >> 3;
            g = pg8::Gemm{(const bf16_t*)(p.ws() + OFF_DFT), (const bf16_t*)(p.ws() + OFF_XTL) + (size_t)b * 256 * 4096, 2048, 256, 4096, 4096, 4096};
            S = pg8::OneUnit{base & 7, 0, prod ? 32 : 0, 32, prod ? 1 : 2, base};
            E.mb = Mo + (size_t)(TC + b * 2048) * DM + 768; }
        else { const int bb = j - 128;
            g = pg8::Gemm{(const bf16_t*)(p.ws() + OFF_DFT256), (const bf16_t*)(p.ws() + OFF_XTC) + (size_t)bb * 256 * 512, 256, 256, 512, 512, 512};
            S = pg8::OneUnit{0, 0, 0, 8, 0, 0};
            E.mb = Mo + (size_t)(bb * 256) * DM + 768; }
        pg8::gemm_phase<EpiFourier, pg8::OneUnit>(lds, g, S, E, tid);
    }
    const bf16_t* HC = (const bf16_t*)(p.ws() + OFF_HC); const bf16_t* BG = (const bf16_t*)(p.ws() + OFF_BG);
    const float* cw = p.in(14) + (size_t)o * 3 * 768; const float* cb = p.in(15) + (size_t)o * 768;
    const int first = G >= 192 ? 128 : 0, nW = G - first;
    if (c >= first) {
        const int stride = nW * 512;
        for (int i0 = (c - first) * 512 + tid; i0 < T * 192; i0 += 4 * stride) {
            u32x2 hm[4], h0[4], hp1[4], bgv[4]; int rowq[4], q4q[4]; bool vq[4];
#pragma unroll
            for (int q = 0; q < 4; ++q) {
                const int i = i0 + q * stride; vq[q] = i < T * 192;
                const int ii = vq[q] ? i : i0;
                const int row = ii / 192, q4 = (ii % 192) * 4; rowq[q] = row; q4q[q] = q4;
                const int L = row < TC ? 256 : 2048, tl = row < TC ? (row & 255) : ((row - TC) & 2047);
                const bf16_t* hp = HC + (size_t)row * 768 + q4;
                h0[q] = *(const u32x2*)hp;
                hm[q] = tl > 0 ? *(const u32x2*)(hp - 768) : (u32x2){0u, 0u};
                hp1[q] = tl < L - 1 ? *(const u32x2*)(hp + 768) : (u32x2){0u, 0u};
                bgv[q] = *(const u32x2*)(BG + (size_t)row * 768 + q4);
            }
#pragma unroll
            for (int q = 0; q < 4; ++q) if (vq[q]) {
                const int q4 = q4q[q];
                const f32x4 w0 = *(const f32x4*)(cw + q4), w1 = *(const f32x4*)(cw + 768 + q4), w2 = *(const f32x4*)(cw + 1536 + q4), bb = *(const f32x4*)(cb + q4);
                const f32x4 z = bb + w0 * up4(hm[q]) + w1 * up4(h0[q]) + w2 * up4(hp1[q]);
                *(u32x2*)(Mo + (size_t)rowq[q] * DM + q4) = pk4(up4(bgv[q]) * z);
            }
        }
    }
}

DI void ffn_fix(const PRef p, const Ctx X, int l) {
    bf16_t* Y = (bf16_t*)(p.ws() + OFF_R1); const float* edge = (const float*)(p.ws() + OFF_EDGE);
    const float* cw = p.in(18) + (size_t)l * 3 * DFF;
    pg8::SplitOrder S; S.init(T, 1024, X.G, X.c, 2816);
    pg8::Unit u;
    for (int i = 0; S.next(i, u); ++i) {
        const int row0 = u.pm * 256;
        if (row0 < TC) continue;
        const int tl0 = (row0 - TC) & 2047;
        const float* e = edge + (size_t)u.pm * 6 * DFF;
        const bool top = tl0 != 0, bot = tl0 + 256 != 2048;
        f32x2 zt[3], gt2[3], at[3], wt[3], zb[3], gb[3], ab[3], wb[3];
#pragma unroll
        for (int k = 0; k < 3; ++k) {
            const int cp = X.tid + 512 * k, ch = 2 * cp;
            if (cp < DFF / 2) {
                if (top) { zt[k] = *(const f32x2*)(e + ch); gt2[k] = *(const f32x2*)(e + DFF + ch); at[k] = *(const f32x2*)(e - 6 * DFF + 5 * DFF + ch); wt[k] = *(const f32x2*)(cw + ch); }
                if (bot) { zb[k] = *(const f32x2*)(e + 3 * DFF + ch); gb[k] = *(const f32x2*)(e + 4 * DFF + ch); ab[k] = *(const f32x2*)(e + 6 * DFF + 2 * DFF + ch); wb[k] = *(const f32x2*)(cw + 2 * DFF + ch); }
            }
        }
#pragma unroll
        for (int k = 0; k < 3; ++k) {
            const int cp = X.tid + 512 * k, ch = 2 * cp;
            if (cp < DFF / 2) {
                if (top) {
                    const f32x4 zz = {zt[k][0] + wt[k][0] * at[k][0], zt[k][1] + wt[k][1] * at[k][1], 0.f, 0.f}, gg = {gt2[k][0], gt2[k][1], 0.f, 0.f};
                    const f32x4 y = silu_mul(zz, gg);
                    *(unsigned*)(Y + (size_t)row0 * DFF + ch) = pk(y[0], y[1]);
                }
                if (bot) {
                    const f32x4 zz = {zb[k][0] + wb[k][0] * ab[k][0], zb[k][1] + wb[k][1] * ab[k][1], 0.f, 0.f}, gg = {gb[k][0], gb[k][1], 0.f, 0.f};
                    const f32x4 y = silu_mul(zz, gg);
                    *(unsigned*)(Y + (size_t)(row0 + 255) * DFF + ch) = pk(y[0], y[1]);
                }
            }
        }
    }
    asm volatile("s_waitcnt vmcnt(0)" ::: "memory");
    __syncthreads();
}


#define XB_TMO      128
#define XB_XCNT(j)  (256  + 64 * (j))
#define XB_XSUB(j)  (1280 + 64 * (j))
#define XB_XGEN(j)  (2304 + 64 * (j))
#define XB_TOP      3328
#define XB_TOPGEN   3392
#define XCD_BAR_WORDS 3456
#define XB_SPIN_CAP (1u << 18)
DI unsigned xb_ld(unsigned* p)              { return __hip_atomic_load(p, __ATOMIC_RELAXED, __HIP_MEMORY_SCOPE_AGENT); }
DI unsigned xb_add(unsigned* p, unsigned v) { return __hip_atomic_fetch_add(p, v, __ATOMIC_RELAXED, __HIP_MEMORY_SCOPE_AGENT); }
DI unsigned xb_xcc_id() { return (unsigned)__builtin_amdgcn_s_getreg((3 << 11) | 20) & 0xFu; }
#define XB_SPIN(cond, bar) do { unsigned _sp = 0; while (cond) { __builtin_amdgcn_s_sleep(1); \
    if ((++_sp & 255u) == 0u) { if (xb_ld(&(bar)[XB_TMO])) break; if (_sp > XB_SPIN_CAP) { atomicAdd(&(bar)[XB_TMO], 1u); break; } } } } while (0)
struct XcdBarrier { unsigned* bar; unsigned x; volatile LAS unsigned* st; };
DI XcdBarrier xcd_barrier_post(unsigned* bar, volatile LAS unsigned* st) {
    XcdBarrier b; b.bar = bar; b.x = xb_xcc_id(); b.st = st;
    if (threadIdx.x == 0) (void)xb_add(&bar[XB_XCNT(b.x)], 1u);
    return b;
}
DI void xcd_barrier_complete(unsigned* bar, unsigned x, unsigned& nloc, unsigned& nx) {
    const unsigned G = gridDim.x * gridDim.y * gridDim.z;
    unsigned sum, cnt, mine, sp = 0u;
    for (;;) {
        sum = 0u; cnt = 0u; mine = 0u;
#pragma unroll
        for (unsigned j = 0; j < 16; ++j) { const unsigned c = xb_ld(&bar[XB_XCNT(j)]); sum += c; cnt += (c > 0u) ? 1u : 0u; mine = (j == x) ? c : mine; }
        if (sum == G) break;
        __builtin_amdgcn_s_sleep(1);
        if ((++sp & 255u) == 0u) { if (xb_ld(&bar[XB_TMO])) break; if (sp > XB_SPIN_CAP) { atomicAdd(&bar[XB_TMO], 1u); break; } }
    }
    nloc = mine > 0u ? mine : 1u; nx = cnt > 0u ? cnt : 1u;
}
DI void xcd_barrier(const XcdBarrier& b) {
    asm volatile("s_waitcnt vmcnt(0)" ::: "memory");
    __syncthreads();
    if (threadIdx.x == 0) {
        unsigned* bar = b.bar;
        __builtin_amdgcn_s_waitcnt(0);
        unsigned nloc = b.st[0], nx = b.st[1];
        if (nloc == 0u) { xcd_barrier_complete(bar, b.x, nloc, nx); b.st[0] = nloc; b.st[1] = nx; }
        const unsigned old = xb_add(&bar[XB_XSUB(b.x)], 1u);
        const unsigned gen = old / nloc;
        if (old + 1u == (gen + 1u) * nloc) {
            __builtin_amdgcn_fence(__ATOMIC_RELEASE, "agent");
            asm volatile("s_waitcnt vmcnt(0)" ::: "memory");
            const unsigned og = xb_add(&bar[XB_TOP], 1u);
            const unsigned tg = og / nx;
            if (og + 1u == (tg + 1u) * nx) xb_add(&bar[XB_TOPGEN], 1u);
            else XB_SPIN(xb_ld(&bar[XB_TOPGEN]) == tg, bar);
            __builtin_amdgcn_fence(__ATOMIC_ACQUIRE, "agent");
            xb_add(&bar[XB_XGEN(b.x)], 1u);
            asm volatile("s_waitcnt vmcnt(0)" ::: "memory");
        } else {
            XB_SPIN(xb_ld(&bar[XB_XGEN(b.x)]) == gen, bar);
            __builtin_amdgcn_fence(__ATOMIC_ACQUIRE, "agent");
            asm volatile("s_waitcnt vmcnt(0)" ::: "memory");
        }
    }
    __syncthreads();
}

__global__ void __launch_bounds__(512, 2) mk_fwd(Params p_) {
    extern __shared__ __attribute__((aligned(16))) unsigned char lds_raw[];
    cg::grid_group grid = cg::this_grid();
    const int ph_lo = p_.ph_lo, ph_hi = p_.ph_hi;
    XcdBarrier xbar; xbar.bar = nullptr; xbar.x = 0; xbar.st = nullptr;
    if (ph_hi - ph_lo > 1) {
        volatile LAS unsigned* st = (volatile LAS unsigned*)((LAS unsigned char*)lds_raw + XBST_OFF);
        if (threadIdx.x == 0) { st[0] = 0u; st[1] = 0u; }
        __syncthreads();
        xbar = xcd_barrier_post((unsigned*)(p_.ws + OFF_BAR), st);
    }
    unsigned long long pr_prev = PROBE_CATS ? __builtin_amdgcn_s_memrealtime() : 0ull, pr_acc = 0ull;
    for (int ph = ph_lo; ph < ph_hi; ++ph) {
        Ctx X; X.tid = threadIdx.x; X.c = blockIdx.x; X.G = gridDim.x;
        asm volatile("" : "+v"(X.tid)); asm volatile("" : "+s"(X.c)); asm volatile("" : "+s"(X.G));
#if defined(__HIP_DEVICE_COMPILE__)
        ParamsPtr pp = (ParamsPtr)__builtin_amdgcn_kernarg_segment_ptr();
        asm volatile("" : "+s"(pp));
#else
        ParamsPtr pp = &p_;
#endif
        const PRef p{pp};
        unsigned lds_u = 0; asm volatile("" : "+s"(lds_u));
        LAS unsigned char* lds = (LAS unsigned char*)lds_raw + lds_u;
        const int G = X.G, c = X.c, tid = X.tid;
        bf16_t* YB = (bf16_t*)(p.ws() + OFF_XB);
        float* STATS = (float*)(p.ws() + OFF_STATS);
        bf16_t* UM = (bf16_t*)(p.ws() + OFF_R1);
        bf16_t* U2 = (bf16_t*)(p.ws() + OFF_R2);
        const float* ada = (const float*)(p.ws() + OFF_ADA);
        if (EN(0) && ph == 0) prep_a(p, X, lds);
        else if (EN(1) && ph == 1) ln_pass<0>(X, p.in(0), p.in(1), nullptr, nullptr, nullptr, UM, nullptr, nullptr, ada + 0, ada + 1024);
        else {
            const int l = (ph - 2) / NSUB, sub = (ph - 2) % NSUB;
            const bool even = (l & 1) == 0; const int eo = l >> 1;
            const float* adal = ada + (size_t)l * 9 * 6144;
            unsigned char* wset = p.ws() + ((l & 1) ? OFF_W2 : OFF_W);
            if (sub == 0) {
                if (EN(2) && even) {
                    pg8::Gemm g{UM, (const bf16_t*)(wset + (OFF_WIN - OFF_W)), T, 1280, 1024, 1024, 1024}; pg8::StaticOrder S; S.init(T, 1280, G, c, 1024);
                    EpiEvenIn E{(bf16_t*)(p.ws() + OFF_Q), (bf16_t*)(p.ws() + OFF_P), (bf16_t*)(p.ws() + OFF_KC), (bf16_t*)(p.ws() + OFF_VTC),
                                (bf16_t*)(p.ws() + OFF_KVL + (size_t)eo * KVL_SZ), (bf16_t*)(p.ws() + OFF_KVL + (size_t)(2 + eo) * KVL_SZ),
                                p.out() + 20971520, p.out() + 22020096, p.in(9) + eo * 64, p.in(10) + eo * 64, (const float*)(p.ws() + OFF_ROPE), eo};
                    pg8::gemm_phase<EpiEvenIn, pg8::StaticOrder>(lds, g, S, E, tid);
                } else if (EN(3)) {
                    pg8::Gemm g{UM, (const bf16_t*)(wset + (OFF_WIN - OFF_W)), T, 2816, 1024, 1024, 1024}; pg8::StaticOrder S; S.init(T, 2816, G, c, 1024);
                    EpiOddIn E{(bf16_t*)(p.ws() + OFF_HC), (bf16_t*)(p.ws() + OFF_BG), (bf16_t*)(p.ws() + OFF_XTC), (bf16_t*)(p.ws() + OFF_XTL)};
                    pg8::gemm_phase<EpiOddIn, pg8::StaticOrder>(lds, g, S, E, tid);
                }
            } else if (sub == 1) {
                if (EN(4) && even) mixer_even(p, X, eo, lds); else if (EN(5) && !even) mixer_odd(p, X, eo, lds);
            } else if (EN(6) && sub == 2) {
                pg8::Gemm g{UM, (const bf16_t*)(wset + (OFF_WOUT - OFF_W)), T, 1024, 1024, 1024, 1024}; pg8::StaticOrder S; S.init(T, 1024, G, c, 1024);
                if (l == 0) { EpiRes<true> E{p.in(0), p.in(1), YB, nullptr, nullptr, nullptr, adal + 2048, nullptr, nullptr};
                    pg8::gemm_phase<EpiRes<true>, pg8::StaticOrder>(lds, g, S, E, tid); }
                else { EpiRes<false> E{nullptr, nullptr, YB, STATS, p.in(21) + (size_t)(l * 2 - 1) * 1024, p.in(22) + (size_t)(l * 2 - 1) * 1024, adal + 2048, nullptr, nullptr};
                    pg8::gemm_phase<EpiRes<false>, pg8::StaticOrder>(lds, g, S, E, tid); }
            } else if (EN(7) && sub == 3) {
                ln_pass<1>(X, nullptr, nullptr, YB, STATS, nullptr, U2, p.in(21) + (size_t)(l * 2) * 1024, p.in(22) + (size_t)(l * 2) * 1024, adal + 3072, adal + 4096);
            } else if (EN(8) && sub == 4) {
                pg8::Gemm g{U2, (const bf16_t*)(wset + (OFF_WUP - OFF_W)), T, 5632, 1024, 1024, 1024}; pg8::StaticOrder S; S.init(T, 5632, G, c, 1024);
                EpiUpConv E{(bf16_t*)(p.ws() + OFF_R1), (float*)(p.ws() + OFF_EDGE), p.in(18) + (size_t)l * 3 * DFF, p.in(19) + (size_t)l * DFF, (LAS float*)(lds + HALO_OFF)};
                pg8::gemm_phase<EpiUpConv, pg8::StaticOrder>(lds, g, S, E, tid);
            } else if (EN(10) && sub == 5) {
                ffn_fix(p, X, l);
                pg8::Gemm g{(const bf16_t*)(p.ws() + OFF_R1), (const bf16_t*)(wset + (OFF_WDN - OFF_W)), T, 1024, 2816, 2816, 2816}; pg8::SplitOrder S; S.init(T, 1024, G, c, 2816);
                EpiRes<false, true> E{nullptr, nullptr, YB, STATS, p.in(21) + (size_t)(l * 2) * 1024, p.in(22) + (size_t)(l * 2) * 1024, adal + 5120,
                                      (float*)(p.ws() + OFF_R2), (unsigned*)(p.ws() + OFF_BAR + 16384) + l * 512};
                pg8::gemm_phase<EpiRes<false, true>, pg8::SplitOrder>(lds, g, S, E, tid);
                if (l < 3) {
                    const int n2 = G == 256 ? 128 : ((T / 256) * 4 > G ? (T / 256) * 4 - G : 0);
                    if (G - n2 >= 64) { if (c >= n2) convert_weights(p, tid, c - n2, G - n2, l + 1, lds, p.ws() + (((l + 1) & 1) ? OFF_W2 : OFF_W)); }
                    else convert_weights(p, tid, c, G, l + 1, lds, p.ws() + (((l + 1) & 1) ? OFF_W2 : OFF_W));
                }
            } else if (EN(11) && sub == 6) {
                const float* lg = p.in(21) + (size_t)(l * 2 + 1) * 1024; const float* lb = p.in(22) + (size_t)(l * 2 + 1) * 1024;
                if (l == 3) ln_pass<2>(X, nullptr, nullptr, YB, STATS, p.out(), nullptr, lg, lb, nullptr, nullptr);
                else ln_pass<1>(X, nullptr, nullptr, YB, STATS, nullptr, UM, lg, lb, adal + 9 * 6144 + 0, adal + 9 * 6144 + 1024);
            }
        }
        if (ph + 1 < ph_hi) { if (ph_hi < 0) grid.sync(); else xcd_barrier(xbar); }
        if (PROBE_CATS) {
            const int sub_ = ph < 2 ? -1 : (ph - 2) % NSUB, l_ = ph < 2 ? 0 : (ph - 2) / NSUB;
            const int cat = ph == 0 ? 0 : ph == 1 ? 1 : sub_ == 0 ? 2 : sub_ == 1 ? ((l_ & 1) ? 4 : 3) : sub_ == 2 ? 5 : (sub_ == 3 || sub_ == 6) ? 1 : sub_ == 4 ? 6 : 8;
            const unsigned long long now = __builtin_amdgcn_s_memrealtime();
            if ((PROBE_CATS >> cat) & 1) pr_acc += now - pr_prev;
            pr_prev = now;
        }
    }
    if (PROBE_CATS && blockIdx.x == 0) {
        const unsigned long long t0 = __builtin_amdgcn_s_memrealtime();
        while (__builtin_amdgcn_s_memrealtime() - t0 < pr_acc) __builtin_amdgcn_s_sleep(8);
    }
}

extern "C" void kernel_launch(void* const* d_in, const int* in_sizes, int n_in, void* d_out, int out_size, void* d_ws, size_t ws_size, hipStream_t stream) {
    static int grid = 0;
    if (grid == 0) {
        int dev = 0, cus = 0, per_cu = 0;
        (void)hipGetDevice(&dev);
        (void)hipDeviceGetAttribute(&cus, hipDeviceAttributeMultiprocessorCount, dev);
        (void)hipFuncSetAttribute((const void*)mk_fwd, hipFuncAttributeMaxDynamicSharedMemorySize, LDS_BYTES);
        (void)hipOccupancyMaxActiveBlocksPerMultiprocessor(&per_cu, (const void*)mk_fwd, 512, LDS_BYTES);
        if (per_cu < 1) { fprintf(stderr, "kernel_launch: occupancy query reports %d blocks per CU\n", per_cu); per_cu = 1; }
        (void)hipGetLastError();
        grid = cus;
        if (n_in != 23 || ws_size < WS_END) { fprintf(stderr, "kernel_launch: n_in %d ws %zu (need %zu)\n", n_in, ws_size, (size_t)WS_END); }
    }
    Params p{};
    for (int i = 0; i < 23; ++i) p.in[i] = (const float*)d_in[i];
    p.out = (float*)d_out; p.ws = (unsigned char*)d_ws;
#if MULTI_LAUNCH
    for (int ph = 0; ph < NPH; ++ph) { p.ph_lo = ph; p.ph_hi = ph + 1; hipLaunchKernelGGL(mk_fwd, dim3(grid), dim3(512), LDS_BYTES, stream, p); }
#else
    p.ph_lo = 0; p.ph_hi = NPH;
    (void)hipMemsetAsync((unsigned char*)d_ws + OFF_BAR, 0, 16384 + 8192 + 12288, stream);
    void* args[] = {&p};
    hipError_t e = hipLaunchCooperativeKernel((const void*)mk_fwd, dim3(grid), dim3(512), args, LDS_BYTES, stream);
    if (e != hipSuccess) fprintf(stderr, "cooperative launch failed: %s (grid %d)\n", hipGetErrorString(e), grid);
#endif
}
```

```cpp
#include <hip/hip_runtime.h>
#include <hip/hip_cooperative_groups.h>
#include <cstdio>
namespace cg = cooperative_groups;

#ifndef PHMASK
#define PHMASK 0xffff
#endif
#define EN(b) ((PHMASK >> (b)) & 1)
#ifndef PROBE_CATS
#define PROBE_CATS 0
#endif
#ifndef MULTI_LAUNCH
#define MULTI_LAUNCH 0
#endif

#define DI __device__ __forceinline__
#define LAS __attribute__((address_space(3)))
typedef unsigned short bf16_t;
typedef short bf16x8 __attribute__((ext_vector_type(8)));
typedef float f32x4 __attribute__((ext_vector_type(4)));
typedef float f32x2 __attribute__((ext_vector_type(2)));
typedef float f32x16 __attribute__((ext_vector_type(16)));
typedef unsigned u32x4 __attribute__((ext_vector_type(4)));
typedef unsigned u32x2 __attribute__((ext_vector_type(2)));
typedef __bf16 bf2_t __attribute__((ext_vector_type(2)));

constexpr int T = 20480, TC = 4096, DM = 1024;
constexpr int DFF = 2816;
constexpr int CH = 10240;
constexpr float ALPHA = 1.6817928305074292f;
constexpr float LN_EPS = 1e-6f, RMS_EPS = 1e-6f;
constexpr float QSCALE = 0.125f * 1.4426950408889634f;
constexpr size_t MiB = 1048576;
constexpr size_t OFF_XB = 0;
constexpr size_t OFF_R1 = 80 * MiB;
constexpr size_t OFF_GB = OFF_R1 + 55 * MiB;
constexpr size_t OFF_R2 = 190 * MiB;
constexpr size_t OFF_Q = OFF_R2, OFF_P = OFF_R2 + 20 * MiB, OFF_KC = OFF_R2 + 40 * MiB, OFF_VTC = OFF_R2 + 41 * MiB;
constexpr size_t OFF_HC = OFF_R2, OFF_BG = OFF_R2 + 30 * MiB, OFF_XTC = OFF_R2 + 60 * MiB, OFF_XTL = OFF_R2 + 64 * MiB;
constexpr size_t OFF_W = 270 * MiB;
constexpr size_t OFF_WIN = OFF_W, OFF_WOUT = OFF_W + 11 * MiB / 2, OFF_WUP = OFF_W + 15 * MiB / 2, OFF_WDN = OFF_W + 37 * MiB / 2;
constexpr size_t OFF_DFT = 294 * MiB;
constexpr size_t OFF_DFT256 = OFF_DFT + 16 * MiB;
constexpr size_t OFF_KVL = 311 * MiB;
constexpr size_t KVL_SZ = (size_t)8 * 2304 * 128 * 2;
constexpr size_t OFF_ADA = 329 * MiB;
constexpr size_t OFF_ROPE = 330 * MiB;
constexpr size_t OFF_EDGE = 331 * MiB;
constexpr size_t OFF_STATS = 337 * MiB;
constexpr size_t OFF_W2 = 338 * MiB;
constexpr size_t OFF_BAR = 362 * MiB;
constexpr size_t WS_END = 363 * MiB;
constexpr int HALO_OFF = 131072;
constexpr int XBST_OFF = 131072 + 4096;
constexpr int LDS_BYTES = 131072 + 4096 + 16;
constexpr int NSUB = 7;
constexpr int NPH = 2 + 4 * NSUB;

struct Params { const float* in[23]; float* out; unsigned char* ws; int ph_lo, ph_hi; };
#if defined(__HIP_DEVICE_COMPILE__)
typedef const __attribute__((address_space(4))) Params* ParamsPtr;
#else
typedef const Params* ParamsPtr;
#endif
struct PRef {
    ParamsPtr q;
    DI const float* in(int k) const { return q->in[k]; }
    DI float* out() const { return q->out; }
    DI unsigned char* ws() const { return q->ws; }
};
struct Ctx { int tid, c, G; };

DI unsigned pk(float lo, float hi) { f32x2 v = {lo, hi}; return __builtin_bit_cast(unsigned, __builtin_convertvector(v, bf2_t)); }
DI float bflo(unsigned u) { return __uint_as_float(u << 16); }
DI float bfhi(unsigned u) { return __uint_as_float(u & 0xffff0000u); }
DI u32x2 pk4(f32x4 v) { u32x2 r; r.x = pk(v[0], v[1]); r.y = pk(v[2], v[3]); return r; }
DI f32x4 up4(u32x2 u) { f32x4 r = {bflo(u.x), bfhi(u.x), bflo(u.y), bfhi(u.y)}; return r; }
DI int cond_of(int row) { return row < TC ? 0 : 1 + ((row - TC) >> 11); }
DI float wsum(float v) {
#pragma unroll
    for (int o = 32; o > 0; o >>= 1) v += __shfl_xor(v, o);
    return v;
}

namespace pg8 {
constexpr int BM = 256, BK = 64, HALF = 128, HTB = HALF * BK * 2, STAGE_BYTES = 8 * HTB, NXCD = 8, WGM = 8;
DI int lds_byte(int r, int c) { const int st = (r >> 4) * 2 + (c >> 5), rr = r & 15, cc = c & 31, ob = rr * 64 + cc * 2; return st * 1024 + (ob ^ (((ob >> 9) & 1) << 5)); }
DI void stage_rc(int b, int& R, int& C) { const int st = b / 1024, sb = b % 1024, swz = sb ^ (((sb >> 9) & 1) << 5); R = (st >> 1) * 16 + swz / 64; C = (st & 1) * 32 + (swz % 64) / 2; }
struct Unit { int pm, pn, kt0, nt, role, slab; };
struct Gemm { const bf16_t* A; const bf16_t* Bt; int M, N, K, lda, ldb; };
struct StaticOrder {
    int nM, nN, nwg, G, c, nt0;
    DI void init(int M, int N, int G_, int c_, int K_ = 1024) { nM = M / BM; nN = N / BM; nwg = nM * nN; G = G_; c = c_; nt0 = K_ / BK; }
    DI bool unit_of(long L, Unit& u) const {
        if (L >= nwg) return false;
        u.kt0 = 0; u.nt = nt0; u.role = 0; u.slab = 0;
        int wgid = (int)L; { const int q = nwg / NXCD, r = nwg % NXCD, xcd = wgid % NXCD, off = wgid / NXCD; wgid = (xcd < r ? xcd * (q + 1) : r * (q + 1) + (xcd - r) * q) + off; }
        const int nig = WGM * nN, gid = wgid / nig, fm = gid * WGM, gsz = (nM - fm) < WGM ? (nM - fm) : WGM;
        u.pm = fm + ((wgid % nig) % gsz); u.pn = (wgid % nig) / gsz; return true;
    }
    DI bool next(int i, Unit& u) const { return unit_of((long)i * G + c, u); }
    DI void a_ready(const Unit&) const {}
    DI void done(const Unit&) const {}
};
struct SplitOrder : StaticOrder {
    DI bool next(int i, Unit& u) const {
        if (G != 256 || nwg != 320) return unit_of((long)i * G + c, u);
        if (i == 0) return unit_of(c, u);
        if (i != 1 || c >= 128) return false;
        unit_of(256 + (c & 63), u); const int h = c >> 6; u.nt = nt0 / 2; u.kt0 = h * (nt0 / 2); u.role = h ? 1 : 2; u.slab = c & 63; return true;
    }
};
struct OneUnit {
    int pm, pn, kt0, nt, role, slab;
    DI bool next(int i, Unit& u) const { if (i != 0) return false; u.pm = pm; u.pn = pn; u.kt0 = kt0; u.nt = nt; u.role = role; u.slab = slab; return true; }
    DI void a_ready(const Unit&) const {}
    DI void done(const Unit&) const {}
};

template <class Epi, class Sched>
DI void gemm_phase(LAS unsigned char* lds, const Gemm g, const Sched& S, const Epi& E, const int tid) {
    const int wid = __builtin_amdgcn_readfirstlane(tid >> 6), lane = tid & 63, wr = wid >> 2, wc = wid & 3, fr = lane & 15, fq = lane >> 4;
    unsigned voffA[2], voffB[2];
#pragma unroll
    for (int i = 0; i < 2; ++i) { int R, C; stage_rc(tid * 16 + i * 8192, R, C); voffA[i] = (unsigned)(R * g.lda + C) * 2u; voffB[i] = (unsigned)(R * g.ldb + C) * 2u; }
    const size_t kstep = (size_t)(BK * 2);
    const size_t hstepA = (size_t)HALF * g.lda * 2, hstepB = (size_t)HALF * g.ldb * 2;
    const size_t tstepA = 2 * hstepA, tstepB = 2 * hstepB;
    const unsigned ldsw = (unsigned)wid * 1024u;
    const int aoff = lds_byte(wr * 64 + fr, fq * 8), boff = lds_byte(wc * 32 + fr, fq * 8);
#define PG8_SA(b, h) (((b) * 2 + (h)) * HTB)
#define PG8_SB(b, h) ((4 + (b) * 2 + (h)) * HTB)
#define PG8_STAGE(bufoff, gbase, voff) do { _Pragma("unroll") for (int _i = 0; _i < 2; ++_i) \
        __builtin_amdgcn_global_load_lds((const unsigned*)((const char*)(gbase) + (voff)[_i]), (LAS unsigned*)(lds + (bufoff) + ldsw + _i * 8192), 16, 0, 0); } while (0)
#define PG8_LDA(dst, b, h) do { _Pragma("unroll") for (int m = 0; m < 4; ++m) _Pragma("unroll") for (int k = 0; k < 2; ++k) dst[m][k] = *(const LAS bf16x8*)(lds + PG8_SA(b, h) + aoff + m * 2048 + k * 1024); } while (0)
#define PG8_LDB(dst, b, h) do { _Pragma("unroll") for (int n = 0; n < 2; ++n) _Pragma("unroll") for (int k = 0; k < 2; ++k) dst[n][k] = *(const LAS bf16x8*)(lds + PG8_SB(b, h) + boff + n * 2048 + k * 1024); } while (0)
#define PG8_MMA(ai, bj, At, Bt) do { __builtin_amdgcn_s_setprio(1); _Pragma("unroll") for (int m = 0; m < 4; ++m) _Pragma("unroll") for (int n = 0; n < 2; ++n) _Pragma("unroll") for (int k = 0; k < 2; ++k) \
        acc[ai][bj][m][n] = __builtin_amdgcn_mfma_f32_16x16x32_bf16(Bt[n][k], At[m][k], acc[ai][bj][m][n], 0, 0, 0); __builtin_amdgcn_s_setprio(0); } while (0)
#define PG8_WAIT_V(n) asm volatile("s_waitcnt vmcnt(" #n ")" ::: "memory")
#define PG8_WAIT_L(n) asm volatile("s_waitcnt lgkmcnt(" #n ")" ::: "memory")
#define PG8_BAR __builtin_amdgcn_s_barrier()
#define PG8_SCHED __builtin_amdgcn_sched_barrier(0)
    Unit cur, nxt; int ui = 0;
    if (!S.next(0, cur)) return;
    f32x4 acc[2][2][4][2];
#pragma unroll
    for (int a = 0; a < 2; ++a)
#pragma unroll
        for (int b = 0; b < 2; ++b)
#pragma unroll
            for (int m = 0; m < 4; ++m)
#pragma unroll
                for (int n = 0; n < 2; ++n) acc[a][b][m][n] = (f32x4){0.f, 0.f, 0.f, 0.f};
    bf16x8 At[4][2], B0[2][2], B1[2][2];
    const char* cA = (const char*)g.A + (size_t)cur.pm * tstepA + (size_t)cur.kt0 * kstep; const char* cB = (const char*)g.Bt + (size_t)cur.pn * tstepB + (size_t)cur.kt0 * kstep;
    S.a_ready(cur);
    PG8_STAGE(PG8_SB(0, 0), cB, voffB); PG8_STAGE(PG8_SA(0, 0), cA, voffA); PG8_STAGE(PG8_SB(0, 1), cB + hstepB, voffB); PG8_STAGE(PG8_SA(0, 1), cA + hstepA, voffA);
    if (wr == 1) PG8_BAR;
    PG8_WAIT_V(4); PG8_BAR;
    PG8_STAGE(PG8_SB(1, 0), cB + kstep, voffB); PG8_STAGE(PG8_SA(1, 0), cA + kstep, voffA); PG8_STAGE(PG8_SB(1, 1), cB + hstepB + kstep, voffB);
    PG8_WAIT_V(6); PG8_BAR;
    for (;;) {
        const bool has_next = S.next(ui + 1, nxt);
        const char* nA = has_next ? (const char*)g.A + (size_t)nxt.pm * tstepA + (size_t)nxt.kt0 * kstep : cA; const char* nB = has_next ? (const char*)g.Bt + (size_t)nxt.pn * tstepB + (size_t)nxt.kt0 * kstep : cB;
        const int nt = cur.nt;
        for (int t = 0; t < nt; t += 2) {
            const bool last = (t == nt - 2);
            const char* a1 = cA + (size_t)(t + 1) * kstep;
            const char* a2 = last ? nA : cA + (size_t)(t + 2) * kstep; const char* b2 = last ? nB : cB + (size_t)(t + 2) * kstep;
            const char* a3 = a2 + kstep; const char* b3 = b2 + kstep;
            if (last && has_next) S.a_ready(nxt);
            PG8_LDB(B0, 0, 0); PG8_SCHED; PG8_LDA(At, 0, 0); PG8_STAGE(PG8_SA(1, 1), a1 + hstepA, voffA);
            PG8_WAIT_L(8); PG8_BAR; PG8_WAIT_L(0); PG8_MMA(0, 0, At, B0); PG8_BAR; PG8_SCHED;
            PG8_LDB(B1, 0, 1); PG8_STAGE(PG8_SB(0, 0), b2, voffB);
            PG8_BAR; PG8_WAIT_L(0); PG8_MMA(0, 1, At, B1); PG8_BAR;
            PG8_LDA(At, 0, 1); PG8_STAGE(PG8_SA(0, 0), a2, voffA);
            PG8_BAR; PG8_WAIT_L(0); PG8_MMA(1, 0, At, B0); PG8_BAR; PG8_SCHED;
            PG8_STAGE(PG8_SB(0, 1), b2 + hstepB, voffB);
            PG8_WAIT_V(6); PG8_BAR; PG8_MMA(1, 1, At, B1); PG8_BAR;
            PG8_LDB(B0, 1, 0); PG8_SCHED; PG8_LDA(At, 1, 0); PG8_STAGE(PG8_SA(0, 1), a2 + hstepA, voffA);
            PG8_WAIT_L(8); PG8_BAR; PG8_WAIT_L(0); PG8_MMA(0, 0, At, B0); PG8_BAR; PG8_SCHED;
            PG8_LDB(B1, 1, 1); PG8_STAGE(PG8_SB(1, 0), b3, voffB);
            PG8_BAR; PG8_WAIT_L(0); PG8_MMA(0, 1, At, B1); PG8_BAR;
            PG8_LDA(At, 1, 1); PG8_STAGE(PG8_SA(1, 0), a3, voffA);
            PG8_BAR; PG8_WAIT_L(0); PG8_MMA(1, 0, At, B0); PG8_BAR; PG8_SCHED;
            PG8_STAGE(PG8_SB(1, 1), b3 + hstepB, voffB);
            PG8_WAIT_V(6); PG8_BAR; PG8_MMA(1, 1, At, B1); PG8_BAR;
        }
        E(acc, cur, wr, wc, fr, fq); S.done(cur);
#if defined(PROBE_EPI2)
        if constexpr (Epi::IDEMP) E(acc, cur, wr, wc, fr, fq);
#endif
        if (!has_next) break;
#pragma unroll
        for (int a = 0; a < 2; ++a)
#pragma unroll
            for (int b = 0; b < 2; ++b)
#pragma unroll
                for (int m = 0; m < 4; ++m)
#pragma unroll
                    for (int n = 0; n < 2; ++n) acc[a][b][m][n] = (f32x4){0.f, 0.f, 0.f, 0.f};
        cur = nxt; cA = nA; cB = nB; ++ui;
    }
    PG8_WAIT_V(0);
    if (wr == 0) PG8_BAR;
    PG8_BAR;
#undef PG8_SA
#undef PG8_SB
#undef PG8_STAGE
#undef PG8_LDA
#undef PG8_LDB
#undef PG8_MMA
#undef PG8_WAIT_V
#undef PG8_WAIT_L
#undef PG8_BAR
#undef PG8_SCHED
}
}

typedef const f32x4 (&AccRef)[2][2][4][2];
DI int lpos(int n) { const int rho = n & 31; return (n & ~31) + 8 * ((rho & 15) >> 2) + 4 * (rho >> 4) + (rho & 3); }
DI int ppos(int c) { const int q = c & 31; return (c & ~31) + 16 * ((q >> 2) & 1) + 4 * (q >> 3) + (q & 3); }

DI void up8(const u32x4 u, f32x4& a, f32x4& b) { a = (f32x4){bflo(u.x), bfhi(u.x), bflo(u.y), bfhi(u.y)}; b = (f32x4){bflo(u.z), bfhi(u.z), bflo(u.w), bfhi(u.w)}; }
DI u32x4 pk8(const f32x4 a, const f32x4 b) { u32x4 r; r.x = pk(a[0], a[1]); r.y = pk(a[2], a[3]); r.z = pk(b[0], b[1]); r.w = pk(b[2], b[3]); return r; }

DI void slab_publish(float* slab, unsigned* flag, AccRef acc, int wid, int lane) {
    float* sp = slab + (size_t)(wid * 64 + lane) * 4;
#pragma unroll
    for (int ai = 0; ai < 2; ++ai)
#pragma unroll
        for (int bj = 0; bj < 2; ++bj)
#pragma unroll
            for (int m = 0; m < 4; ++m)
#pragma unroll
                for (int n = 0; n < 2; ++n) {
                    float* q_ = sp + (size_t)((((ai * 2 + bj) * 4 + m) * 2 + n)) * 2048; const f32x4 v_ = acc[ai][bj][m][n];
                    asm volatile("global_store_dwordx4 %0, %1, off sc0 sc1\n\ts_nop 1" :: "v"(q_), "v"(v_) : "memory"); }
    asm volatile("s_waitcnt vmcnt(0)" ::: "memory");
    if (lane == 0) __hip_atomic_store(flag + wid, 1u, __ATOMIC_RELAXED, __HIP_MEMORY_SCOPE_AGENT);
}
DI void slab_wait(unsigned* flag, int wid) {
    unsigned sp = 0;
    while (__hip_atomic_load(flag + wid, __ATOMIC_RELAXED, __HIP_MEMORY_SCOPE_AGENT) == 0u) { __builtin_amdgcn_s_sleep(2); if (++sp > (1u << 22)) break; }
    __builtin_amdgcn_fence(__ATOMIC_ACQUIRE, "agent");
    asm volatile("s_waitcnt vmcnt(0)" ::: "memory");
}
DI f32x4 slab_get(const float* slab, int ai, int bj, int m, int n, int wid, int lane) {
    return *(const f32x4*)(slab + (size_t)((((ai * 2 + bj) * 4 + m) * 2 + n)) * 2048 + (size_t)(wid * 64 + lane) * 4);
}

template <bool FIRST, bool SPLIT = false>
struct EpiRes {
    static constexpr bool IDEMP = false;
    const float* xc; const float* xl; bf16_t* Y; const float* stats; const float* lng; const float* lnb; const float* gate; float* slabs; unsigned* flags;
    DI void operator()(AccRef acc, const pg8::Unit& u, int wr, int wc, int fr, int fq) const {
        const int wid = wr * 4 + wc, lane = fr + 16 * fq;
        if (SPLIT && u.role == 1) { slab_publish(slabs + (size_t)u.slab * 65536, flags + u.slab * 8, acc, wid, lane); return; }
        const bool add = SPLIT && u.role == 2;
        const float* sl = slabs + (size_t)u.slab * 65536;
        if (add) slab_wait(flags + u.slab * 8, wid);
        const int col0 = u.pn * 256 + wc * 32 + 8 * fq;
        const float* gr = gate + cond_of(u.pm * 256) * 6144;
        f32x4 gt[2][2], lg[2][2], lb[2][2];
#pragma unroll
        for (int bj = 0; bj < 2; ++bj)
#pragma unroll
            for (int n = 0; n < 2; ++n) { const int c = col0 + bj * 128 + 4 * n; gt[bj][n] = *(const f32x4*)(gr + c);
                if (!FIRST) { lg[bj][n] = *(const f32x4*)(lng + c); lb[bj][n] = *(const f32x4*)(lnb + c); } }
#pragma unroll
        for (int ai = 0; ai < 2; ++ai)
#pragma unroll
            for (int m = 0; m < 4; ++m) {
                const int row = u.pm * 256 + ai * 128 + wr * 64 + m * 16 + fr;
                bf16_t* yr = Y + (size_t)row * DM;
                f32x2 st = {0.f, 0.f};
                if (!FIRST) st = *(const f32x2*)(stats + (size_t)row * 2);
#pragma unroll
                for (int bj = 0; bj < 2; ++bj) {
                    const int c = col0 + bj * 128;
                    f32x4 x0, x1;
                    if (FIRST) { const float* xr = row < TC ? xc + (size_t)row * DM : xl + (size_t)(row - TC) * DM; x0 = *(const f32x4*)(xr + c); x1 = *(const f32x4*)(xr + c + 4); }
                    else { up8(*(const u32x4*)(yr + c), x0, x1);
                        x0 = (x0 - st[0]) * st[1] * lg[bj][0] + lb[bj][0];
                        x1 = (x1 - st[0]) * st[1] * lg[bj][1] + lb[bj][1]; }
                    f32x4 a0 = acc[ai][bj][m][0], a1 = acc[ai][bj][m][1];
                    if (add) { a0 += slab_get(sl, ai, bj, m, 0, wid, lane); a1 += slab_get(sl, ai, bj, m, 1, wid, lane); }
                    *(u32x4*)(yr + c) = pk8(ALPHA * x0 + gt[bj][0] * a0, ALPHA * x1 + gt[bj][1] * a1);
                }
            }
    }
};

struct EpiEvenIn {
    static constexpr bool IDEMP = false;
    bf16_t* Q; bf16_t* P; bf16_t* Kc; bf16_t* VTc; bf16_t* Kl; bf16_t* VTl; float* outk; float* outv;
    const float* qg; const float* kg; const float* rope; int e;
    DI void operator()(AccRef acc, const pg8::Unit& u, int wr, int wc, int fr, int fq) const {
        const int pn = u.pn;
        if (pn >= 3) {
#pragma unroll
            for (int ai = 0; ai < 2; ++ai)
#pragma unroll
                for (int m = 0; m < 4; ++m) {
                    const int row = u.pm * 256 + ai * 128 + wr * 64 + m * 16 + fr;
                    bf16_t* pr = P + (size_t)row * 512 + (pn - 3) * 256 + wc * 32 + 8 * fq;
#pragma unroll
                    for (int bj = 0; bj < 2; ++bj)
#pragma unroll
                        for (int n = 0; n < 2; ++n) *(u32x2*)(pr + bj * 128 + n * 4) = pk4(acc[ai][bj][m][n]);
                }
            return;
        }
        const bool is_v = (pn == 2 && wc >= 2);
        const float* gw = pn < 2 ? qg : kg;
        f32x4 gh[2][2];
#pragma unroll
        for (int bj = 0; bj < 2; ++bj)
#pragma unroll
            for (int n = 0; n < 2; ++n) gh[bj][n] = *(const f32x4*)(gw + 32 * bj + 8 * fq + 4 * n);
#pragma unroll
        for (int ai = 0; ai < 2; ++ai)
#pragma unroll
            for (int m = 0; m < 4; ++m) {
                const int row = u.pm * 256 + ai * 128 + wr * 64 + m * 16 + fr;
                const bool latent = row >= TC;
                const int tpos = (row - TC) & 2047, b = (row - TC) >> 11;
                f32x4 v[2][2];
#pragma unroll
                for (int bj = 0; bj < 2; ++bj)
#pragma unroll
                    for (int n = 0; n < 2; ++n) v[bj][n] = acc[ai][bj][m][n];
                if (!is_v) {
                    float ss = 0.f;
#pragma unroll
                    for (int bj = 0; bj < 2; ++bj)
#pragma unroll
                        for (int n = 0; n < 2; ++n)
#pragma unroll
                            for (int j = 0; j < 4; ++j) ss += v[bj][n][j] * v[bj][n][j];
                    ss += __shfl_xor(ss, 16); ss += __shfl_xor(ss, 32);
                    const float rs = rsqrtf(ss * (1.0f / 64.0f) + RMS_EPS);
#pragma unroll
                    for (int bj = 0; bj < 2; ++bj)
#pragma unroll
                        for (int n = 0; n < 2; ++n) {
                            const int d = 32 * bj + 8 * fq + 4 * n;
                            v[bj][n] = v[bj][n] * rs * gh[bj][n];
                            if (latent) {
                                const f32x4 cs = *(const f32x4*)(rope + ((size_t)tpos * 32 + (d >> 1)) * 2);
                                const float x0 = v[bj][n][0], x1 = v[bj][n][1], x2 = v[bj][n][2], x3 = v[bj][n][3];
                                v[bj][n][0] = x0 * cs[0] - x1 * cs[1]; v[bj][n][1] = x0 * cs[1] + x1 * cs[0];
                                v[bj][n][2] = x2 * cs[2] - x3 * cs[3]; v[bj][n][3] = x2 * cs[3] + x3 * cs[2];
                            }
                        }
                }
                if (pn < 2) {
                    bf16_t* qr = Q + (size_t)row * 512 + (pn * 4 + wc) * 64 + 8 * fq;
#pragma unroll
                    for (int bj = 0; bj < 2; ++bj)
#pragma unroll
                        for (int n = 0; n < 2; ++n) *(u32x2*)(qr + 32 * bj + 4 * n) = pk4(v[bj][n] * QSCALE);
                } else if (!is_v) {
                    const int h = wc;
                    if (!latent) {
                        const int bb = row >> 8, t = row & 255;
                        float* ok = outk + ((size_t)(bb * 2 + e) * 256 + t) * 128 + h * 64 + 8 * fq;
                        bf16_t* kr = Kc + (size_t)row * 128 + h * 64 + 8 * fq;
#pragma unroll
                        for (int bj = 0; bj < 2; ++bj)
#pragma unroll
                            for (int n = 0; n < 2; ++n) { *(f32x4*)(ok + 32 * bj + 4 * n) = v[bj][n]; *(u32x2*)(kr + 32 * bj + 4 * n) = pk4(v[bj][n]); }
                    } else {
                        bf16_t* kr = Kl + ((size_t)b * 2304 + tpos) * 128 + h * 64 + 8 * fq;
#pragma unroll
                        for (int bj = 0; bj < 2; ++bj)
#pragma unroll
                            for (int n = 0; n < 2; ++n) *(u32x2*)(kr + 32 * bj + 4 * n) = pk4(v[bj][n]);
                    }
                } else {
                    const int h = wc - 2;
                    if (!latent) {
                        const int bb = row >> 8, t = row & 255;
                        float* ov = outv + ((size_t)(bb * 2 + e) * 256 + t) * 128 + h * 64 + 8 * fq;
                        bf16_t* vr = VTc + ((size_t)(bb * 2 + h) * 64 + 8 * fq) * 256 + t;
#pragma unroll
                        for (int bj = 0; bj < 2; ++bj)
#pragma unroll
                            for (int n = 0; n < 2; ++n) {
                                *(f32x4*)(ov + 32 * bj + 4 * n) = v[bj][n];
                                const u32x2 pv = pk4(v[bj][n]);
                                bf16_t* vp = vr + (size_t)(32 * bj + 4 * n) * 256;
                                vp[0] = (bf16_t)(pv.x & 0xffff); vp[256] = (bf16_t)(pv.x >> 16); vp[512] = (bf16_t)(pv.y & 0xffff); vp[768] = (bf16_t)(pv.y >> 16);
                            }
                    } else {
                        bf16_t* vr = VTl + ((size_t)(b * 2 + h) * 64 + 8 * fq) * 2304 + tpos;
#pragma unroll
                        for (int bj = 0; bj < 2; ++bj)
#pragma unroll
                            for (int n = 0; n < 2; ++n) {
                                const u32x2 pv = pk4(v[bj][n]);
                                bf16_t* vp = vr + (size_t)(32 * bj + 4 * n) * 2304;
                                vp[0] = (bf16_t)(pv.x & 0xffff); vp[2304] = (bf16_t)(pv.x >> 16); vp[4608] = (bf16_t)(pv.y & 0xffff); vp[6912] = (bf16_t)(pv.y >> 16);
                            }
                    }
                }
                __builtin_amdgcn_sched_barrier(0);
            }
    }
};

struct EpiOddIn {
    static constexpr bool IDEMP = false;
    bf16_t* HC; bf16_t* BG; bf16_t* XTc; bf16_t* XTl;
    DI void operator()(AccRef acc, const pg8::Unit& u, int wr, int wc, int fr, int fq) const {
        const int pn = u.pn;
#pragma unroll
        for (int ai = 0; ai < 2; ++ai)
#pragma unroll
            for (int m = 0; m < 4; ++m) {
                const int row = u.pm * 256 + ai * 128 + wr * 64 + m * 16 + fr;
                if (pn < 6) {
                    bf16_t* hr = HC + (size_t)row * 768 + pn * 128 + wc * 32 + 8 * fq;
#pragma unroll
                    for (int n = 0; n < 2; ++n) *(u32x2*)(hr + 4 * n) = pk4(acc[ai][0][m][n] * acc[ai][1][m][n]);
                } else if (pn < 9) {
                    bf16_t* br = BG + (size_t)row * 768 + (pn - 6) * 256 + wc * 32 + 8 * fq;
#pragma unroll
                    for (int bj = 0; bj < 2; ++bj)
#pragma unroll
                        for (int n = 0; n < 2; ++n) *(u32x2*)(br + bj * 128 + n * 4) = pk4(acc[ai][bj][m][n]);
                } else {
                    const int part = pn - 9;
                    bf16_t* xr; size_t cs;
                    if (row < TC) { const int bb = row >> 8, t = row & 255; cs = 512; xr = XTc + (size_t)bb * 256 * 512 + part * 256 + t; }
                    else { const int b = (row - TC) >> 11, t = (row - TC) & 2047; cs = 4096; xr = XTl + (size_t)b * 256 * 4096 + part * 2048 + t; }
#pragma unroll
                    for (int bj = 0; bj < 2; ++bj)
#pragma unroll
                        for (int n = 0; n < 2; ++n) {
                            const u32x2 pv = pk4(acc[ai][bj][m][n]);
                            bf16_t* xp = xr + (size_t)(bj * 128 + wc * 32 + n * 4 + 8 * fq) * cs;
                            xp[0] = (bf16_t)(pv.x & 0xffff); xp[cs] = (bf16_t)(pv.x >> 16); xp[2 * cs] = (bf16_t)(pv.y & 0xffff); xp[3 * cs] = (bf16_t)(pv.y >> 16);
                        }
                }
            }
    }
};

DI f32x4 silu_mul(f32x4 z, f32x4 g) {
    f32x4 y;
#pragma unroll
    for (int j = 0; j < 4; ++j) y[j] = z[j] * __builtin_amdgcn_rcpf(1.0f + __builtin_amdgcn_exp2f(-1.4426950408889634f * z[j])) * g[j];
    return y;
}
struct EpiUpConv {
    static constexpr bool IDEMP = true;
    bf16_t* Y; float* edge; const float* cw; const float* cb; LAS float* halo;
    DI void operator()(AccRef acc, const pg8::Unit& u, int wr, int wc, int fr, int fq) const {
        const int lane = fr + 16 * fq, chl = wc * 32 + 8 * fq, ch0 = u.pn * 128 + chl;
        f32x4 w0h[2], w1h[2], w2h[2], bbh[2];
#pragma unroll
        for (int n = 0; n < 2; ++n) { w0h[n] = *(const f32x4*)(cw + ch0 + 4 * n); w1h[n] = *(const f32x4*)(cw + DFF + ch0 + 4 * n); w2h[n] = *(const f32x4*)(cw + 2 * DFF + ch0 + 4 * n); bbh[n] = *(const f32x4*)(cb + ch0 + 4 * n); }
#pragma unroll
        for (int ai = 0; ai < 2; ++ai)
#pragma unroll
            for (int n = 0; n < 2; ++n) {
                if (fr == 0) *(LAS f32x4*)(halo + ((ai * 2 + wr) * 2 + 0) * 128 + chl + 4 * n) = acc[ai][0][0][n];
                if (fr == 15) *(LAS f32x4*)(halo + ((ai * 2 + wr) * 2 + 1) * 128 + chl + 4 * n) = acc[ai][0][3][n];
            }
        asm volatile("s_waitcnt lgkmcnt(0)" ::: "memory");
        __builtin_amdgcn_s_barrier(); __builtin_amdgcn_s_barrier();
        asm volatile("" ::: "memory");
        const int lprev = (lane & 48) | ((fr + 15) & 15), lnext = (lane & 48) | ((fr + 1) & 15);
        float* eg = edge + (size_t)u.pm * 6 * DFF + ch0;
#pragma unroll
        for (int n = 0; n < 2; ++n) {
            const f32x4 w0 = w0h[n], w1 = w1h[n], w2 = w2h[n], bb = bbh[n];
#pragma unroll
            for (int ai = 0; ai < 2; ++ai) {
                const int blk = ai * 2 + wr;
                f32x4 uph = {0.f, 0.f, 0.f, 0.f}, dnh = {0.f, 0.f, 0.f, 0.f};
                if (blk > 0) uph = *(const LAS f32x4*)(halo + ((blk - 1) * 2 + 1) * 128 + chl + 4 * n);
                if (blk < 3) dnh = *(const LAS f32x4*)(halo + ((blk + 1) * 2 + 0) * 128 + chl + 4 * n);
                f32x4 rr[4], rl[4];
#pragma unroll
                for (int m = 0; m < 4; ++m)
#pragma unroll
                    for (int j = 0; j < 4; ++j) { rr[m][j] = __shfl(acc[ai][0][m][n][j], lprev); rl[m][j] = __shfl(acc[ai][0][m][n][j], lnext); }
#pragma unroll
                for (int m = 0; m < 4; ++m) {
                    const f32x4 prev = fr > 0 ? rr[m] : (m > 0 ? rr[m > 0 ? m - 1 : 0] : uph);
                    const f32x4 next = fr < 15 ? rl[m] : (m < 3 ? rl[m < 3 ? m + 1 : 3] : dnh);
                    const f32x4 a = acc[ai][0][m][n], g = acc[ai][1][m][n];
                    const f32x4 z = bb + w0 * prev + w1 * a + w2 * next;
                    const int row = u.pm * 256 + ai * 128 + wr * 64 + m * 16 + fr;
                    *(u32x2*)(Y + (size_t)row * DFF + ch0 + 4 * n) = pk4(silu_mul(z, g));
                    if (ai == 0 && m == 0 && wr == 0 && fr == 0) { *(f32x4*)(eg + 4 * n) = z; *(f32x4*)(eg + DFF + 4 * n) = g; *(f32x4*)(eg + 2 * DFF + 4 * n) = a; }
                    if (ai == 1 && m == 3 && wr == 1 && fr == 15) { *(f32x4*)(eg + 3 * DFF + 4 * n) = z; *(f32x4*)(eg + 4 * DFF + 4 * n) = g; *(f32x4*)(eg + 5 * DFF + 4 * n) = a; }
                }
            }
        }
    }
};

struct EpiFourier {
    static constexpr bool IDEMP = false;
    bf16_t* mb;
    float* slabs; unsigned* flags;
    DI void operator()(AccRef acc, const pg8::Unit& u, int wr, int wc, int fr, int fq) const {
        const int wid = wr * 4 + wc, lane = fr + 16 * fq;
        if (u.role == 1) { slab_publish(slabs + (size_t)u.slab * 65536, flags + u.slab * 8, acc, wid, lane); return; }
        const bool add = u.role == 2;
        if (add) slab_wait(flags + u.slab * 8, wid);
        const float* sl = slabs + (size_t)u.slab * 65536;
#pragma unroll
        for (int ai = 0; ai < 2; ++ai)
#pragma unroll
            for (int m = 0; m < 4; ++m) {
                const int row = u.pm * 256 + ai * 128 + wr * 64 + m * 16 + fr;
                bf16_t* mr = mb + (size_t)row * DM + wc * 32 + 4 * fq;
                f32x4 sv[2][2];
                if (add) {
#pragma unroll
                    for (int bj = 0; bj < 2; ++bj)
#pragma unroll
                        for (int n = 0; n < 2; ++n) sv[bj][n] = slab_get(sl, ai, bj, m, n, wid, lane);
                }
#pragma unroll
                for (int bj = 0; bj < 2; ++bj)
#pragma unroll
                    for (int n = 0; n < 2; ++n) {
                        f32x4 a = acc[ai][bj][m][n];
                        if (add) a += sv[bj][n];
                        *(u32x2*)(mr + bj * 128 + n * 16) = pk4(a);
                    }
            }
    }
};

struct TrJob { const float* src; bf16_t* dst; int ld, Kd, k0, n0, type; };
DI int tr_srccol(int type, int np) {
    const int n = lpos(np);
    if (type == 0) return n < 768 ? ((n & ~255) + ((n >> 5) & 3) * 64 + ((n >> 7) & 1) * 32 + (n & 31)) : n;
    if (type == 1) return n < 1536 ? ((((n >> 7) & 1) ? 1536 : 0) + (n >> 8) * 128 + (n & 127)) : (768 + (n - 1536));
    if (type == 3) return (((n >> 7) & 1) ? 2816 : 0) + (n >> 8) * 128 + (n & 127);
    return n;
}

DI void convert_weights(const PRef p, const int tid, const int cc, const int GG, int l, LAS unsigned char* lds, unsigned char* wbase) {
    LAS float* t = (LAS float*)lds;
    const int G = GG, c = cc;
    const bool even = (l & 1) == 0; const int eo = l >> 1;
    bf16_t* WIN = (bf16_t*)(wbase); bf16_t* WOUT = (bf16_t*)(wbase + (OFF_WOUT - OFF_W)); bf16_t* WUP = (bf16_t*)(wbase + (OFF_WUP - OFF_W)); bf16_t* WDN = (bf16_t*)(wbase + (OFF_WDN - OFF_W));
    const float* w_out = p.in(16) + (size_t)l * 1024 * 1024;
    const float* w_up = p.in(17) + (size_t)l * 1024 * 5632;
    const float* w_dn = p.in(20) + (size_t)l * 2816 * 1024;
    const int n_in = even ? 20 * 16 : 36 * 16;
    const int n_out = even ? 16 * 8 : 16 * 16;
    const int n_up = 88 * 16, n_dn = 16 * 44;
    const int total = n_in + n_out + n_up + n_dn;
    for (int j0 = c; j0 < total; j0 += 4 * G) {
        TrJob jb[4];
#pragma unroll
        for (int qi = 0; qi < 4; ++qi) {
            int q = j0 + qi * G; TrJob J; J.type = -1; J.src = nullptr; J.dst = nullptr; J.ld = 0; J.Kd = 0; J.k0 = 0; J.n0 = 0;
            if (q < total) {
                if (q < n_in) { J.n0 = (q >> 4) * 64; J.k0 = (q & 15) * 64; J.dst = WIN; J.Kd = 1024;
                    if (even) { J.src = p.in(8) + (size_t)eo * 1024 * 1280; J.ld = 1280; J.type = 0; } else { J.src = p.in(13) + (size_t)eo * 1024 * 2560; J.ld = 2560; J.type = 1; } }
                else if ((q -= n_in) < n_out) { J.n0 = (even ? (q >> 3) : (q >> 4)) * 64; J.k0 = (even ? (q & 7) : (q & 15)) * 64; J.src = w_out; J.ld = 1024; J.dst = WOUT; J.Kd = 1024; J.type = 2; }
                else if ((q -= n_out) < n_up) { J.n0 = (q >> 4) * 64; J.k0 = (q & 15) * 64; J.src = w_up; J.ld = 5632; J.dst = WUP; J.Kd = 1024; J.type = 3; }
                else { q -= n_up; J.n0 = (q / 44) * 64; J.k0 = (q % 44) * 64; J.src = w_dn; J.ld = 1024; J.dst = WDN; J.Kd = 2816; J.type = 2; }
            }
            jb[qi] = J;
        }
        float rg[4][8];
        { const int nn = tid & 63, kk = tid >> 6;
#pragma unroll
          for (int qi = 0; qi < 4; ++qi) if (jb[qi].type >= 0) { const int sc = tr_srccol(jb[qi].type, jb[qi].n0 + nn);
#pragma unroll
              for (int i = 0; i < 8; ++i) rg[qi][i] = jb[qi].src[(size_t)(jb[qi].k0 + kk + 8 * i) * jb[qi].ld + sc]; }
#pragma unroll
          for (int qi = 0; qi < 4; ++qi) if (jb[qi].type >= 0) {
#pragma unroll
              for (int i = 0; i < 8; ++i) t[qi * 4160 + (kk + 8 * i) * 65 + nn] = rg[qi][i]; } }
        __syncthreads();
        { const int kp = tid & 31, nr = tid >> 5;
#pragma unroll
          for (int qi = 0; qi < 4; ++qi) if (jb[qi].type >= 0) {
#pragma unroll
              for (int i = 0; i < 4; ++i) { const int n = nr + 16 * i; const float a = t[qi * 4160 + (2 * kp) * 65 + n], b = t[qi * 4160 + (2 * kp + 1) * 65 + n];
                  *(unsigned*)(jb[qi].dst + (size_t)(jb[qi].n0 + n) * jb[qi].Kd + jb[qi].k0 + 2 * kp) = pk(a, b); } } }
        __syncthreads();
    }
    if (even) {
        const float* wp = p.in(11) + (size_t)eo * 4 * 128 * 128; const float* sc = p.in(12) + (size_t)eo * 512;
        for (int uu = c; uu < 256; uu += G) {
            const int g = uu >> 6, c0 = (uu & 63) * 2;
            __syncthreads();
            if (tid < 256) { const int cc = tid >> 7, d = tid & 127; t[tid] = wp[((size_t)g * 128 + c0 + cc) * 128 + d] * sc[g * 128 + d]; }
            __syncthreads();
            float a00 = 0.f, a01 = 0.f, a10 = 0.f, a11 = 0.f;
            const float* wo = w_out + (size_t)(512 + g * 128) * 1024;
#pragma unroll 8
            for (int d = 0; d < 128; ++d) {
                const float w0 = wo[(size_t)d * 1024 + tid], w1 = wo[(size_t)d * 1024 + 512 + tid];
                const float k0 = t[d], k1 = t[128 + d];
                a00 += k0 * w0; a01 += k1 * w0; a10 += k0 * w1; a11 += k1 * w1;
            }
            *(unsigned*)(WOUT + (size_t)ppos(tid) * 1024 + 512 + g * 128 + c0) = pk(a00, a01);
            *(unsigned*)(WOUT + (size_t)ppos(tid + 512) * 1024 + 512 + g * 128 + c0) = pk(a10, a11);
        }
    } else {
        const float* wf = p.in(13) + (size_t)eo * 1024 * 2560 + 2304;
        __syncthreads();
        if (tid < 64) { float s, co; sincospif((float)tid * (1.0f / 32.0f), &s, &co); t[512 + tid] = co; t[576 + tid] = s; }
        for (int uu = c; uu < 512; uu += G) {
            __syncthreads();
            t[tid] = wf[(size_t)(2 * uu + (tid >> 8)) * 2560 + (tid & 255)];
            __syncthreads();
            const int part = tid >> 8, ch = tid & 255, g = ch >> 6, mm = ch & 63;
            float a0 = 0.f, a1 = 0.f;
            for (int cc = 0; cc < 64; ++cc) { const float tw = t[512 + part * 64 + ((mm * cc) & 63)]; a0 += tw * t[g * 64 + cc]; a1 += tw * t[256 + g * 64 + cc]; }
            *(unsigned*)(WIN + (size_t)(2304 + ppos(tid)) * 1024 + 2 * uu) = pk(a0, a1);
        }
        __syncthreads();
    }
}

DI void prep_a(const PRef p, const Ctx X, LAS unsigned char* lds) {
    const int G = X.G, c = X.c, tid = X.tid, wid = tid >> 6, lane = tid & 63;
    {
        LAS float* sc = (LAS float*)lds;
        LAS float* part = sc + 9 * 1024;
        for (int i = tid; i < 9 * 1024; i += 512) { const int j = i >> 10, k = i & 1023; const float x = j == 0 ? p.in(5)[k] : p.in(4)[(size_t)(j - 1) * 1024 + k]; sc[i] = x / (1.0f + __expf(-x)); }
        __syncthreads();
        float* ada = (float*)(p.ws() + OFF_ADA);
        for (int uu = c; uu < 192; uu += G) {
            const int l = uu / 48, cb = uu % 48;
            const float* w = p.in(6) + (size_t)l * 1024 * 6144 + cb * 128 + 2 * lane;
            float a0[9], a1[9];
#pragma unroll
            for (int j = 0; j < 9; ++j) { a0[j] = 0.f; a1[j] = 0.f; }
            const int k0 = wid * 128;
#pragma unroll 32
            for (int k = 0; k < 128; ++k) { const f32x2 wv = *(const f32x2*)(w + (size_t)(k0 + k) * 6144);
#pragma unroll
                for (int j = 0; j < 9; ++j) { const float sv = sc[j * 1024 + k0 + k]; a0[j] += sv * wv[0]; a1[j] += sv * wv[1]; } }
#pragma unroll
            for (int j = 0; j < 9; ++j) *(LAS f32x2*)(part + (wid * 9 + j) * 128 + 2 * lane) = (f32x2){a0[j], a1[j]};
            __syncthreads();
            for (int i = tid; i < 9 * 128; i += 512) { const int j = i >> 7, cc = i & 127; float sm = 0.f;
#pragma unroll
                for (int w8 = 0; w8 < 8; ++w8) sm += part[(w8 * 9 + j) * 128 + cc];
                ada[((size_t)l * 9 + j) * 6144 + cb * 128 + cc] = sm + p.in(7)[(size_t)l * 6144 + cb * 128 + cc]; }
            __syncthreads();
        }
    }
    convert_weights(p, tid, c, G, 0, lds, p.ws() + OFF_W);
    const int gt = c * 512 + tid, GT = G * 512;
    {
        bf16_t* D = (bf16_t*)(p.ws() + OFF_DFT);
        const float s = 1.0f / 362.03867196751236f;
        for (int i = gt; i < 2048 * 1024; i += GT) { const int k = i >> 10, t2 = (i & 1023) * 2;
            float s0, c0, s1, c1; sincospif((float)((k * t2) & 2047) * (1.0f / 1024.0f), &s0, &c0); sincospif((float)((k * (t2 + 1)) & 2047) * (1.0f / 1024.0f), &s1, &c1);
            *(unsigned*)(D + (size_t)k * 4096 + t2) = pk(c0 * s, c1 * s); *(unsigned*)(D + (size_t)k * 4096 + 2048 + t2) = pk(-s0 * s, -s1 * s); }
        bf16_t* D2 = (bf16_t*)(p.ws() + OFF_DFT256);
        const float s2 = 1.0f / 128.0f;
        for (int i = gt; i < 256 * 128; i += GT) { const int k = i >> 7, t2 = (i & 127) * 2;
            float s0, c0, s1, c1; sincospif((float)((k * t2) & 255) * (1.0f / 128.0f), &s0, &c0); sincospif((float)((k * (t2 + 1)) & 255) * (1.0f / 128.0f), &s1, &c1);
            *(unsigned*)(D2 + (size_t)k * 512 + t2) = pk(c0 * s2, c1 * s2); *(unsigned*)(D2 + (size_t)k * 512 + 256 + t2) = pk(-s0 * s2, -s1 * s2); }
    }
    {
        float* R = (float*)(p.ws() + OFF_ROPE);
        for (int i = gt; i < 2048 * 32; i += GT) { const int t = i >> 5, f = i & 31; const float pos = (float)(f < 16 ? (t >> 6) : (t & 63));
            const float inv = 1.0f / powf(10000.0f, (float)(f & 15) * (1.0f / 16.0f)); const float ang = pos * inv; R[2 * i] = cosf(ang); R[2 * i + 1] = sinf(ang); }
    }
    {
        for (int i = gt; i < 8 * 2 * 256 * 128; i += GT) {
            const int col = i & 127, s = (i >> 7) & 255, e = (i >> 15) & 1, b = i >> 16;
            bf16_t* Kl = (bf16_t*)(p.ws() + OFF_KVL + (size_t)e * KVL_SZ); bf16_t* VTl = (bf16_t*)(p.ws() + OFF_KVL + (size_t)(2 + e) * KVL_SZ);
            const unsigned kv = pk(p.in(2)[i], 0.f), vv = pk(p.in(3)[i], 0.f);
            Kl[((size_t)b * 2304 + 2048 + s) * 128 + col] = (bf16_t)(kv & 0xffff);
            const int h = col >> 6, d = col & 63;
            VTl[((size_t)(b * 2 + h) * 64 + d) * 2304 + 2048 + s] = (bf16_t)(vv & 0xffff);
        }
    }
}

template <int MODE>
DI void ln_pass(const Ctx X, const float* srcc, const float* srcl, const bf16_t* Y, float* stats, float* xout, bf16_t* udst, const float* lng, const float* lnb, const float* adash, const float* adasc) {
    const int lane = X.tid & 63, GWV = X.G * 8, RPW = (T + GWV - 1) / GWV;
    const int gw = (X.c * 8 + (X.tid >> 6)) * RPW, rend = gw + RPW < T ? gw + RPW : T;
    const int cb = lane * 8;
    f32x4 nf[4]; u32x4 nb[2];
#define LN_LOAD(R) do { const int r_ = (R); if (MODE == 0) { const float* src = r_ < TC ? srcc + (size_t)r_ * DM : srcl + (size_t)(r_ - TC) * DM; \
            nf[0] = *(const f32x4*)(src + cb); nf[1] = *(const f32x4*)(src + cb + 4); nf[2] = *(const f32x4*)(src + cb + 512); nf[3] = *(const f32x4*)(src + cb + 516); } \
        else { nb[0] = *(const u32x4*)(Y + (size_t)r_ * DM + cb); nb[1] = *(const u32x4*)(Y + (size_t)r_ * DM + cb + 512); } } while (0)
    f32x4 hg[4], hb[4];
    if (MODE != 0) {
#pragma unroll
        for (int i = 0; i < 4; ++i) { const int c = cb + (i >> 1) * 512 + (i & 1) * 4; hg[i] = *(const f32x4*)(lng + c); hb[i] = *(const f32x4*)(lnb + c); }
    }
    if (gw < T) LN_LOAD(gw);
    int cdh = -1; f32x4 hs[4], hh[4];
    for (int row = gw; row < rend; ++row) {
        f32x4 v[4];
        if (MODE == 0) {
#pragma unroll
            for (int i = 0; i < 4; ++i) v[i] = nf[i];
        } else { up8(nb[0], v[0], v[1]); up8(nb[1], v[2], v[3]); }
        if (row + 1 < rend) LN_LOAD(row + 1);
        if (MODE != 0) {
            float s1 = 0.f, s2 = 0.f;
#pragma unroll
            for (int i = 0; i < 4; ++i)
#pragma unroll
                for (int j = 0; j < 4; ++j) { s1 += v[i][j]; s2 += v[i][j] * v[i][j]; }
#pragma unroll
            for (int o = 32; o > 0; o >>= 1) { s1 += __shfl_xor(s1, o); s2 += __shfl_xor(s2, o); }
            const float mu = s1 * (1.0f / 1024.0f);
            const float rstd = rsqrtf(fmaxf(s2 * (1.0f / 1024.0f) - mu * mu, 0.f) + LN_EPS);
            if (MODE == 1 && lane == 0) *(f32x2*)(stats + (size_t)row * 2) = (f32x2){mu, rstd};
#pragma unroll
            for (int i = 0; i < 4; ++i) { const int c = cb + (i >> 1) * 512 + (i & 1) * 4;
                v[i] = (v[i] - mu) * rstd * hg[i] + hb[i];
                if (MODE == 2) *(f32x4*)(xout + (size_t)row * DM + c) = v[i]; }
        }
        if (MODE != 2) {
            float s1 = 0.f, s2 = 0.f;
#pragma unroll
            for (int i = 0; i < 4; ++i)
#pragma unroll
                for (int j = 0; j < 4; ++j) { s1 += v[i][j]; s2 += v[i][j] * v[i][j]; }
#pragma unroll
            for (int o = 32; o > 0; o >>= 1) { s1 += __shfl_xor(s1, o); s2 += __shfl_xor(s2, o); }
            const float mu = s1 * (1.0f / 1024.0f);
            const float rstd = rsqrtf(fmaxf(s2 * (1.0f / 1024.0f) - mu * mu, 0.f) + LN_EPS);
            const int cd = cond_of(row);
            if (cd != cdh) { cdh = cd;
#pragma unroll
                for (int i = 0; i < 4; ++i) { const int c = cb + (i >> 1) * 512 + (i & 1) * 4; hs[i] = 1.0f + *(const f32x4*)(adasc + cd * 6144 + c); hh[i] = *(const f32x4*)(adash + cd * 6144 + c); } }
            f32x4 o4[4];
#pragma unroll
            for (int i = 0; i < 4; ++i) o4[i] = (v[i] - mu) * rstd * hs[i] + hh[i];
            *(u32x4*)(udst + (size_t)row * DM + cb) = pk8(o4[0], o4[1]);
            *(u32x4*)(udst + (size_t)row * DM + cb + 512) = pk8(o4[2], o4[3]);
        }
    }
#undef LN_LOAD
}

constexpr int KROW = 144, VROW = 136, KBUF = 64 * KROW, VBUF = 64 * VROW, ABUF = KBUF + VBUF;
template <int VSTR>
DI void attn_tile(LAS unsigned char* kb_, LAS unsigned char* vb_, const int r, const int h, const bf16x8 (&qf)[4], f32x16 (&o)[2], float& mrun, float& lsum) {
        bf16x8 kf[2][4];
#pragma unroll
        for (int kb = 0; kb < 2; ++kb)
#pragma unroll
            for (int ks = 0; ks < 4; ++ks) kf[kb][ks] = *(const LAS bf16x8*)(kb_ + (kb * 32 + r) * KROW + (16 * ks + 8 * h) * 2);
        __builtin_amdgcn_sched_barrier(0);
        f32x16 s[2];
#pragma unroll
        for (int kb = 0; kb < 2; ++kb) {
#pragma unroll
            for (int i = 0; i < 16; ++i) s[kb][i] = 0.f;
#pragma unroll
            for (int ks = 0; ks < 4; ++ks) s[kb] = __builtin_amdgcn_mfma_f32_32x32x16_bf16(kf[kb][ks], qf[ks], s[kb], 0, 0, 0);
        }
        u32x2 vf[2][2][2][2];
#pragma unroll
        for (int kb = 0; kb < 2; ++kb)
#pragma unroll
            for (int st = 0; st < 2; ++st)
#pragma unroll
                for (int db = 0; db < 2; ++db) {
                    const LAS unsigned char* va = vb_ + (db * 32 + r) * VSTR + (kb * 32 + 16 * st + 4 * h) * 2;
                    vf[kb][st][db][0] = *(const LAS u32x2*)va; vf[kb][st][db][1] = *(const LAS u32x2*)(va + 16);
                }
        __builtin_amdgcn_sched_barrier(0);
        float mx = s[0][0];
#pragma unroll
        for (int i = 1; i < 16; ++i) mx = fmaxf(mx, s[0][i]);
#pragma unroll
        for (int i = 0; i < 16; ++i) mx = fmaxf(mx, s[1][i]);
        mx = fmaxf(mx, __shfl_xor(mx, 32));
        if (__builtin_amdgcn_ballot_w64(mx > mrun) != 0ull) {
            const float mnew = fmaxf(mrun, mx);
            const float al = __builtin_amdgcn_exp2f(mrun - mnew);
            mrun = mnew; lsum *= al;
#pragma unroll
            for (int i = 0; i < 16; ++i) { o[0][i] *= al; o[1][i] *= al; }
        }
        float ps = 0.f;
#pragma unroll
        for (int kb = 0; kb < 2; ++kb)
#pragma unroll
            for (int i = 0; i < 16; ++i) { s[kb][i] = __builtin_amdgcn_exp2f(s[kb][i] - mrun); ps += s[kb][i]; }
        lsum += ps;
        bf16x8 pf[2][2];
#pragma unroll
        for (int kb = 0; kb < 2; ++kb)
#pragma unroll
            for (int st = 0; st < 2; ++st) {
                u32x4 pp;
                pp.x = pk(s[kb][8 * st + 0], s[kb][8 * st + 1]); pp.y = pk(s[kb][8 * st + 2], s[kb][8 * st + 3]);
                pp.z = pk(s[kb][8 * st + 4], s[kb][8 * st + 5]); pp.w = pk(s[kb][8 * st + 6], s[kb][8 * st + 7]);
                pf[kb][st] = __builtin_bit_cast(bf16x8, pp);
            }
        __builtin_amdgcn_sched_barrier(0);
#pragma unroll
        for (int kb = 0; kb < 2; ++kb)
#pragma unroll
            for (int st = 0; st < 2; ++st)
#pragma unroll
                for (int db = 0; db < 2; ++db) {
                    const u32x4 vv = {vf[kb][st][db][0].x, vf[kb][st][db][0].y, vf[kb][st][db][1].x, vf[kb][st][db][1].y};
                    o[db] = __builtin_amdgcn_mfma_f32_32x32x16_bf16(__builtin_bit_cast(bf16x8, vv), pf[kb][st], o[db], 0, 0, 0);
                }
        __builtin_amdgcn_sched_barrier(0);
}

DI void attn_unit(const int tid, LAS unsigned char* lds, const bf16_t* Q, const bf16_t* Kb, const bf16_t* VTb, int Lk, bf16_t* Mo, int q0row, int kvh) {
    const int wid = tid >> 6, lane = tid & 63, r = lane & 31, h = lane >> 5;
    const int head = kvh * 4 + (wid & 3);
    const int qrow = q0row + (wid >> 2) * 32 + r;
    bf16x8 qf[4];
#pragma unroll
    for (int ks = 0; ks < 4; ++ks) qf[ks] = *(const bf16x8*)(Q + (size_t)qrow * 512 + head * 64 + 16 * ks + 8 * h);
    const int srow = tid >> 3, sch = tid & 7;
    const bf16_t* kg = Kb + (size_t)srow * 128 + sch * 8;
    const bf16_t* vg = VTb + (size_t)srow * Lk + sch * 8;
    const int nt = Lk >> 6;
    u32x4 kreg0 = *(const u32x4*)kg, vreg0 = *(const u32x4*)vg;
    u32x4 kreg1 = *(const u32x4*)(kg + (size_t)64 * 128), vreg1 = *(const u32x4*)(vg + 64);
    __syncthreads();
    *(LAS u32x4*)(lds + srow * KROW + sch * 16) = kreg0;
    *(LAS u32x2*)(lds + KBUF + srow * VROW + sch * 16) = (u32x2){vreg0.x, vreg0.y};
    *(LAS u32x2*)(lds + KBUF + srow * VROW + sch * 16 + 8) = (u32x2){vreg0.z, vreg0.w};
    __syncthreads();
    f32x16 o[2];
#pragma unroll
    for (int i = 0; i < 16; ++i) { o[0][i] = 0.f; o[1][i] = 0.f; }
    float mrun = -1e30f, lsum = 0.f;
#define ATT_STEP(T_, KCUR, VCUR, KNXT, VNXT) do { const int t = (T_); \
        LAS unsigned char* kb_ = lds + (t & 1) * ABUF; LAS unsigned char* vb_ = kb_ + KBUF; \
        if (t + 2 < nt) { KCUR = *(const u32x4*)(kg + (size_t)(t + 2) * 64 * 128); VCUR = *(const u32x4*)(vg + (t + 2) * 64); } \
        attn_tile<VROW>(kb_, vb_, r, h, qf, o, mrun, lsum); \
        if (t + 1 < nt) { LAS unsigned char* nb = lds + ((t + 1) & 1) * ABUF; \
            *(LAS u32x4*)(nb + srow * KROW + sch * 16) = KNXT; \
            *(LAS u32x2*)(nb + KBUF + srow * VROW + sch * 16) = (u32x2){VNXT.x, VNXT.y}; \
            *(LAS u32x2*)(nb + KBUF + srow * VROW + sch * 16 + 8) = (u32x2){VNXT.z, VNXT.w}; } \
        __syncthreads(); } while (0)
    for (int t2 = 0; t2 < nt; t2 += 2) {
        ATT_STEP(t2, kreg0, vreg0, kreg1, vreg1);
        ATT_STEP(t2 + 1, kreg1, vreg1, kreg0, vreg0);
    }
#undef ATT_STEP
    const float lt = lsum + __shfl_xor(lsum, 32);
    const float inv = 1.0f / lt;
    bf16_t* mo = Mo + (size_t)qrow * DM + head * 64 + 4 * h;
#pragma unroll
    for (int db = 0; db < 2; ++db)
#pragma unroll
        for (int g = 0; g < 4; ++g) {
            const f32x4 ov = {o[db][4 * g] * inv, o[db][4 * g + 1] * inv, o[db][4 * g + 2] * inv, o[db][4 * g + 3] * inv};
            *(u32x2*)(mo + db * 32 + g * 8) = pk4(ov);
        }
}

constexpr int CVS = 520, CKALL = 256 * KROW;
DI void attn_unit_ctx(const int tid, LAS unsigned char* lds, const bf16_t* Q, const bf16_t* Kb, const bf16_t* VTb, bf16_t* Mo, int q0row, int kvh) {
    const int wid = tid >> 6, lane = tid & 63, r = lane & 31, h = lane >> 5;
    const int head = kvh * 4 + (wid & 3);
    const int qrow = q0row + (wid >> 2) * 32 + r;
    bf16x8 qf[4];
#pragma unroll
    for (int ks = 0; ks < 4; ++ks) qf[ks] = *(const bf16x8*)(Q + (size_t)qrow * 512 + head * 64 + 16 * ks + 8 * h);
    const int srow = tid >> 3, sch = tid & 7;
    u32x4 kr[4], vr[4];
#pragma unroll
    for (int i = 0; i < 4; ++i) { kr[i] = *(const u32x4*)(Kb + (size_t)(srow + 64 * i) * 128 + sch * 8); vr[i] = *(const u32x4*)(VTb + (size_t)srow * 256 + (sch + 8 * i) * 8); }
    __syncthreads();
#pragma unroll
    for (int i = 0; i < 4; ++i) {
        *(LAS u32x4*)(lds + (srow + 64 * i) * KROW + sch * 16) = kr[i];
        LAS unsigned char* vp = lds + CKALL + srow * CVS + (sch + 8 * i) * 16;
        *(LAS u32x2*)vp = (u32x2){vr[i].x, vr[i].y}; *(LAS u32x2*)(vp + 8) = (u32x2){vr[i].z, vr[i].w};
    }
    __syncthreads();
    f32x16 o[2];
#pragma unroll
    for (int i = 0; i < 16; ++i) { o[0][i] = 0.f; o[1][i] = 0.f; }
    float mrun = -1e30f, lsum = 0.f;
#pragma unroll
    for (int t = 0; t < 4; ++t) attn_tile<CVS>(lds + t * 64 * KROW, lds + CKALL + t * 128, r, h, qf, o, mrun, lsum);
    const float lt = lsum + __shfl_xor(lsum, 32);
    const float inv = 1.0f / lt;
    bf16_t* mo = Mo + (size_t)qrow * DM + head * 64 + 4 * h;
#pragma unroll
    for (int db = 0; db < 2; ++db)
#pragma unroll
        for (int g = 0; g < 4; ++g) {
            const f32x4 ov = {o[db][4 * g] * inv, o[db][4 * g + 1] * inv, o[db][4 * g + 2] * inv, o[db][4 * g + 3] * inv};
            *(u32x2*)(mo + db * 32 + g * 8) = pk4(ov);
        }
}

template <int H>
DI void pool_block(const bf16_t* Pc, bf16_t* Mc, const int seq0, const int L, const int tl0) {
    unsigned v[32 + 2 * H];
#pragma unroll
    for (int i = 0; i < 32 + 2 * H; ++i) { const int j = tl0 - H + i; v[i] = (j >= 0 && j < L) ? *(const unsigned*)(Pc + (size_t)(seq0 + j) * 512) : 0u; }
    float s0 = 0.f, s1 = 0.f;
#pragma unroll
    for (int k = 0; k < 2 * H; ++k) { s0 += bflo(v[k]); s1 += bfhi(v[k]); }
#pragma unroll
    for (int i = 0; i < 32; ++i) {
        const int tl = tl0 + i;
        const int lo = tl - H > 0 ? tl - H : 0, hi = tl + H < L ? tl + H : L;
        const float ic = 1.0f / (float)(hi - lo);
        *(unsigned*)(Mc + (size_t)(seq0 + tl) * DM) = pk(s0 * ic - bflo(v[i + H]), s1 * ic - bfhi(v[i + H]));
        s0 += bflo(v[i + 2 * H]) - bflo(v[i]); s1 += bfhi(v[i + 2 * H]) - bfhi(v[i]);
    }
}

DI void mixer_even(const PRef p, const Ctx X, int e, LAS unsigned char* lds) {
    const int G = X.G, c = X.c, tid = X.tid;
    const bf16_t* Q = (const bf16_t*)(p.ws() + OFF_Q); const bf16_t* P = (const bf16_t*)(p.ws() + OFF_P);
    const bf16_t* Kc = (const bf16_t*)(p.ws() + OFF_KC); const bf16_t* VTc = (const bf16_t*)(p.ws() + OFF_VTC);
    const bf16_t* Kl = (const bf16_t*)(p.ws() + OFF_KVL + (size_t)e * KVL_SZ); const bf16_t* VTl = (const bf16_t*)(p.ws() + OFF_KVL + (size_t)(2 + e) * KVL_SZ);
    bf16_t* Mo = (bf16_t*)(p.ws() + OFF_R1);
    for (int u = c; u < 512; u += G) {
        const int pr = G == 256 ? 2 * (c & 7) + (u >> 8) : (u >> 5), qb = G == 256 ? (c >> 3) : (u & 31);
        const int b = pr >> 1, kvh = pr & 1;
        attn_unit(tid, lds, Q, Kl + (size_t)b * 2304 * 128 + kvh * 64, VTl + (size_t)(b * 2 + kvh) * 64 * 2304, 2304, Mo, TC + b * 2048 + qb * 64, kvh);
    }
    for (int u = c; u < 128; u += G) {
        const int bb = u >> 3, kvh = (u >> 2) & 1, qb = u & 3;
        attn_unit_ctx(tid, lds, Q, Kc + (size_t)bb * 256 * 128 + kvh * 64, VTc + (size_t)(bb * 2 + kvh) * 64 * 256, Mo, bb * 256 + qb * 64, kvh);
    }
    for (int u = G - 1 - c; u < 320; u += G) {
        const int row0 = u * 64 + (tid >> 8) * 32;
        const int seq0 = row0 < TC ? (row0 & ~255) : TC + ((row0 - TC) & ~2047);
        const int L = row0 < TC ? 256 : 2048;
        const int cp = tid & 255, grp = cp >> 6;
        const bf16_t* Pc = P + 2 * cp; bf16_t* Mc = Mo + 512 + 2 * cp;
        if (grp == 0) pool_block<1>(Pc, Mc, seq0, L, row0 - seq0);
        else if (grp == 1) pool_block<2>(Pc, Mc, seq0, L, row0 - seq0);
        else if (grp == 2) pool_block<4>(Pc, Mc, seq0, L, row0 - seq0);
        else pool_block<8>(Pc, Mc, seq0, L, row0 - seq0);
    }
}

DI void mixer_odd(const PRef p, const Ctx X, int o, LAS unsigned char* lds) {
    const int G = X.G, c = X.c, tid = X.tid;
    bf16_t* Mo = (bf16_t*)(p.ws() + OFF_R1);
    float* fsl = (float*)(p.ws() + OFF_R1 + 56 * MiB); unsigned* ffl = (unsigned*)(p.ws() + OFF_BAR + 16384 + 8192) + o * 1536;
    const int jstep = G == 256 ? 128 : G;
    for (int j = c; j < 144 && (G != 256 || c < 128); j += jstep) {
        pg8::Gemm g; pg8::OneUnit S; EpiFourier E; E.slabs = fsl; E.flags = ffl;
        if (j < 128) { const int prod = j < 64, base = j & 63, b = base >> 3;
            g = pg8::Gemm{(const bf16_t*)(p.ws() + OFF_DFT), (const bf16_t*)(p.ws() + OFF_XTL) + (size_t)b * 256 * 4096, 2048, 256, 4096, 4096, 4096};
            S = pg8::OneUnit{base & 7, 0, prod ? 32 : 0, 32, prod ? 1 : 2, base};
            E.mb = Mo + (size_t)(TC + b * 2048) * DM + 768; }
        else { const int bb = j - 128;
            g = pg8::Gemm{(const bf16_t*)(p.ws() + OFF_DFT256), (const bf16_t*)(p.ws() + OFF_XTC) + (size_t)bb * 256 * 512, 256, 256, 512, 512, 512};
            S = pg8::OneUnit{0, 0, 0, 8, 0, 0};
            E.mb = Mo + (size_t)(bb * 256) * DM + 768; }
        pg8::gemm_phase<EpiFourier, pg8::OneUnit>(lds, g, S, E, tid);
    }
    const bf16_t* HC = (const bf16_t*)(p.ws() + OFF_HC); const bf16_t* BG = (const bf16_t*)(p.ws() + OFF_BG);
    const float* cw = p.in(14) + (size_t)o * 3 * 768; const float* cb = p.in(15) + (size_t)o * 768;
    const int first = G >= 192 ? 128 : 0, nW = G - first;
    if (c >= first) {
        const int stride = nW * 512;
        for (int i0 = (c - first) * 512 + tid; i0 < T * 192; i0 += 4 * stride) {
            u32x2 hm[4], h0[4], hp1[4], bgv[4]; int rowq[4], q4q[4]; bool vq[4];
#pragma unroll
            for (int q = 0; q < 4; ++q) {
                const int i = i0 + q * stride; vq[q] = i < T * 192;
                const int ii = vq[q] ? i : i0;
                const int row = ii / 192, q4 = (ii % 192) * 4; rowq[q] = row; q4q[q] = q4;
                const int L = row < TC ? 256 : 2048, tl = row < TC ? (row & 255) : ((row - TC) & 2047);
                const bf16_t* hp = HC + (size_t)row * 768 + q4;
                h0[q] = *(const u32x2*)hp;
                hm[q] = tl > 0 ? *(const u32x2*)(hp - 768) : (u32x2){0u, 0u};
                hp1[q] = tl < L - 1 ? *(const u32x2*)(hp + 768) : (u32x2){0u, 0u};
                bgv[q] = *(const u32x2*)(BG + (size_t)row * 768 + q4);
            }
#pragma unroll
            for (int q = 0; q < 4; ++q) if (vq[q]) {
                const int q4 = q4q[q];
                const f32x4 w0 = *(const f32x4*)(cw + q4), w1 = *(const f32x4*)(cw + 768 + q4), w2 = *(const f32x4*)(cw + 1536 + q4), bb = *(const f32x4*)(cb + q4);
                const f32x4 z = bb + w0 * up4(hm[q]) + w1 * up4(h0[q]) + w2 * up4(hp1[q]);
                *(u32x2*)(Mo + (size_t)rowq[q] * DM + q4) = pk4(up4(bgv[q]) * z);
            }
        }
    }
}

DI void ffn_fix(const PRef p, const Ctx X, int l) {
    bf16_t* Y = (bf16_t*)(p.ws() + OFF_R1); const float* edge = (const float*)(p.ws() + OFF_EDGE);
    const float* cw = p.in(18) + (size_t)l * 3 * DFF;
    pg8::SplitOrder S; S.init(T, 1024, X.G, X.c, 2816);
    pg8::Unit u;
    for (int i = 0; S.next(i, u); ++i) {
        const int row0 = u.pm * 256;
        if (row0 < TC) continue;
        const int tl0 = (row0 - TC) & 2047;
        const float* e = edge + (size_t)u.pm * 6 * DFF;
        const bool top = tl0 != 0, bot = tl0 + 256 != 2048;
        f32x2 zt[3], gt2[3], at[3], wt[3], zb[3], gb[3], ab[3], wb[3];
#pragma unroll
        for (int k = 0; k < 3; ++k) {
            const int cp = X.tid + 512 * k, ch = 2 * cp;
            if (cp < DFF / 2) {
                if (top) { zt[k] = *(const f32x2*)(e + ch); gt2[k] = *(const f32x2*)(e + DFF + ch); at[k] = *(const f32x2*)(e - 6 * DFF + 5 * DFF + ch); wt[k] = *(const f32x2*)(cw + ch); }
                if (bot) { zb[k] = *(const f32x2*)(e + 3 * DFF + ch); gb[k] = *(const f32x2*)(e + 4 * DFF + ch); ab[k] = *(const f32x2*)(e + 6 * DFF + 2 * DFF + ch); wb[k] = *(const f32x2*)(cw + 2 * DFF + ch); }
            }
        }
#pragma unroll
        for (int k = 0; k < 3; ++k) {
            const int cp = X.tid + 512 * k, ch = 2 * cp;
            if (cp < DFF / 2) {
                if (top) {
                    const f32x4 zz = {zt[k][0] + wt[k][0] * at[k][0], zt[k][1] + wt[k][1] * at[k][1], 0.f, 0.f}, gg = {gt2[k][0], gt2[k][1], 0.f, 0.f};
                    const f32x4 y = silu_mul(zz, gg);
                    *(unsigned*)(Y + (size_t)row0 * DFF + ch) = pk(y[0], y[1]);
                }
                if (bot) {
                    const f32x4 zz = {zb[k][0] + wb[k][0] * ab[k][0], zb[k][1] + wb[k][1] * ab[k][1], 0.f, 0.f}, gg = {gb[k][0], gb[k][1], 0.f, 0.f};
                    const f32x4 y = silu_mul(zz, gg);
                    *(unsigned*)(Y + (size_t)(row0 + 255) * DFF + ch) = pk(y[0], y[1]);
                }
            }
        }
    }
    asm volatile("s_waitcnt vmcnt(0)" ::: "memory");
    __syncthreads();
}


#define XB_TMO      128
#define XB_XCNT(j)  (256  + 64 * (j))
#define XB_XSUB(j)  (1280 + 64 * (j))
#define XB_XGEN(j)  (2304 + 64 * (j))
#define XB_TOP      3328
#define XB_TOPGEN   3392
#define XCD_BAR_WORDS 3456
#define XB_SPIN_CAP (1u << 18)
DI unsigned xb_ld(unsigned* p)              { return __hip_atomic_load(p, __ATOMIC_RELAXED, __HIP_MEMORY_SCOPE_AGENT); }
DI unsigned xb_add(unsigned* p, unsigned v) { return __hip_atomic_fetch_add(p, v, __ATOMIC_RELAXED, __HIP_MEMORY_SCOPE_AGENT); }
DI unsigned xb_xcc_id() { return (unsigned)__builtin_amdgcn_s_getreg((3 << 11) | 20) & 0xFu; }
#define XB_SPIN(cond, bar) do { unsigned _sp = 0; while (cond) { __builtin_amdgcn_s_sleep(1); \
    if ((++_sp & 255u) == 0u) { if (xb_ld(&(bar)[XB_TMO])) break; if (_sp > XB_SPIN_CAP) { atomicAdd(&(bar)[XB_TMO], 1u); break; } } } } while (0)
struct XcdBarrier { unsigned* bar; unsigned x; volatile LAS unsigned* st; };
DI XcdBarrier xcd_barrier_post(unsigned* bar, volatile LAS unsigned* st) {
    XcdBarrier b; b.bar = bar; b.x = xb_xcc_id(); b.st = st;
    if (threadIdx.x == 0) (void)xb_add(&bar[XB_XCNT(b.x)], 1u);
    return b;
}
DI void xcd_barrier_complete(unsigned* bar, unsigned x, unsigned& nloc, unsigned& nx) {
    const unsigned G = gridDim.x * gridDim.y * gridDim.z;
    unsigned sum, cnt, mine, sp = 0u;
    for (;;) {
        sum = 0u; cnt = 0u; mine = 0u;
#pragma unroll
        for (unsigned j = 0; j < 16; ++j) { const unsigned c = xb_ld(&bar[XB_XCNT(j)]); sum += c; cnt += (c > 0u) ? 1u : 0u; mine = (j == x) ? c : mine; }
        if (sum == G) break;
        __builtin_amdgcn_s_sleep(1);
        if ((++sp & 255u) == 0u) { if (xb_ld(&bar[XB_TMO])) break; if (sp > XB_SPIN_CAP) { atomicAdd(&bar[XB_TMO], 1u); break; } }
    }
    nloc = mine > 0u ? mine : 1u; nx = cnt > 0u ? cnt : 1u;
}
DI void xcd_barrier(const XcdBarrier& b) {
    asm volatile("s_waitcnt vmcnt(0)" ::: "memory");
    __syncthreads();
    if (threadIdx.x == 0) {
        unsigned* bar = b.bar;
        __builtin_amdgcn_s_waitcnt(0);
        unsigned nloc = b.st[0], nx = b.st[1];
        if (nloc == 0u) { xcd_barrier_complete(bar, b.x, nloc, nx); b.st[0] = nloc; b.st[1] = nx; }
        const unsigned old = xb_add(&bar[XB_XSUB(b.x)], 1u);
        const unsigned gen = old / nloc;
        if (old + 1u == (gen + 1u) * nloc) {
            __builtin_amdgcn_fence(__ATOMIC_RELEASE, "agent");
            asm volatile("s_waitcnt vmcnt(0)" ::: "memory");
            const unsigned og = xb_add(&bar[XB_TOP], 1u);
            const unsigned tg = og / nx;
            if (og + 1u == (tg + 1u) * nx) xb_add(&bar[XB_TOPGEN], 1u);
            else XB_SPIN(xb_ld(&bar[XB_TOPGEN]) == tg, bar);
            __builtin_amdgcn_fence(__ATOMIC_ACQUIRE, "agent");
            xb_add(&bar[XB_XGEN(b.x)], 1u);
            asm volatile("s_waitcnt vmcnt(0)" ::: "memory");
        } else {
            XB_SPIN(xb_ld(&bar[XB_XGEN(b.x)]) == gen, bar);
            __builtin_amdgcn_fence(__ATOMIC_ACQUIRE, "agent");
            asm volatile("s_waitcnt vmcnt(0)" ::: "memory");
        }
    }
    __syncthreads();
}

__global__ void __launch_bounds__(512, 2) mk_fwd(Params p_) {
    extern __shared__ __attribute__((aligned(16))) unsigned char lds_raw[];
    cg::grid_group grid = cg::this_grid();
    const int ph_lo = p_.ph_lo, ph_hi = p_.ph_hi;
    XcdBarrier xbar; xbar.bar = nullptr; xbar.x = 0; xbar.st = nullptr;
    if (ph_hi - ph_lo > 1) {
        volatile LAS unsigned* st = (volatile LAS unsigned*)((LAS unsigned char*)lds_raw + XBST_OFF);
        if (threadIdx.x == 0) { st[0] = 0u; st[1] = 0u; }
        __syncthreads();
        xbar = xcd_barrier_post((unsigned*)(p_.ws + OFF_BAR), st);
    }
    unsigned long long pr_prev = PROBE_CATS ? __builtin_amdgcn_s_memrealtime() : 0ull, pr_acc = 0ull;
    for (int ph = ph_lo; ph < ph_hi; ++ph) {
        Ctx X; X.tid = threadIdx.x; X.c = blockIdx.x; X.G = gridDim.x;
        asm volatile("" : "+v"(X.tid)); asm volatile("" : "+s"(X.c)); asm volatile("" : "+s"(X.G));
#if defined(__HIP_DEVICE_COMPILE__)
        ParamsPtr pp = (ParamsPtr)__builtin_amdgcn_kernarg_segment_ptr();
        asm volatile("" : "+s"(pp));
#else
        ParamsPtr pp = &p_;
#endif
        const PRef p{pp};
        unsigned lds_u = 0; asm volatile("" : "+s"(lds_u));
        LAS unsigned char* lds = (LAS unsigned char*)lds_raw + lds_u;
        const int G = X.G, c = X.c, tid = X.tid;
        bf16_t* YB = (bf16_t*)(p.ws() + OFF_XB);
        float* STATS = (float*)(p.ws() + OFF_STATS);
        bf16_t* UM = (bf16_t*)(p.ws() + OFF_R1);
        bf16_t* U2 = (bf16_t*)(p.ws() + OFF_R2);
        const float* ada = (const float*)(p.ws() + OFF_ADA);
        if (EN(0) && ph == 0) prep_a(p, X, lds);
        else if (EN(1) && ph == 1) ln_pass<0>(X, p.in(0), p.in(1), nullptr, nullptr, nullptr, UM, nullptr, nullptr, ada + 0, ada + 1024);
        else {
            const int l = (ph - 2) / NSUB, sub = (ph - 2) % NSUB;
            const bool even = (l & 1) == 0; const int eo = l >> 1;
            const float* adal = ada + (size_t)l * 9 * 6144;
            unsigned char* wset = p.ws() + ((l & 1) ? OFF_W2 : OFF_W);
            if (sub == 0) {
                if (EN(2) && even) {
                    pg8::Gemm g{UM, (const bf16_t*)(wset + (OFF_WIN - OFF_W)), T, 1280, 1024, 1024, 1024}; pg8::StaticOrder S; S.init(T, 1280, G, c, 1024);
                    EpiEvenIn E{(bf16_t*)(p.ws() + OFF_Q), (bf16_t*)(p.ws() + OFF_P), (bf16_t*)(p.ws() + OFF_KC), (bf16_t*)(p.ws() + OFF_VTC),
                                (bf16_t*)(p.ws() + OFF_KVL + (size_t)eo * KVL_SZ), (bf16_t*)(p.ws() + OFF_KVL + (size_t)(2 + eo) * KVL_SZ),
                                p.out() + 20971520, p.out() + 22020096, p.in(9) + eo * 64, p.in(10) + eo * 64, (const float*)(p.ws() + OFF_ROPE), eo};
                    pg8::gemm_phase<EpiEvenIn, pg8::StaticOrder>(lds, g, S, E, tid);
                } else if (EN(3)) {
                    pg8::Gemm g{UM, (const bf16_t*)(wset + (OFF_WIN - OFF_W)), T, 2816, 1024, 1024, 1024}; pg8::StaticOrder S; S.init(T, 2816, G, c, 1024);
                    EpiOddIn E{(bf16_t*)(p.ws() + OFF_HC), (bf16_t*)(p.ws() + OFF_BG), (bf16_t*)(p.ws() + OFF_XTC), (bf16_t*)(p.ws() + OFF_XTL)};
                    pg8::gemm_phase<EpiOddIn, pg8::StaticOrder>(lds, g, S, E, tid);
                }
            } else if (sub == 1) {
                if (EN(4) && even) mixer_even(p, X, eo, lds); else if (EN(5) && !even) mixer_odd(p, X, eo, lds);
            } else if (EN(6) && sub == 2) {
                pg8::Gemm g{UM, (const bf16_t*)(wset + (OFF_WOUT - OFF_W)), T, 1024, 1024, 1024, 1024}; pg8::StaticOrder S; S.init(T, 1024, G, c, 1024);
                if (l == 0) { EpiRes<true> E{p.in(0), p.in(1), YB, nullptr, nullptr, nullptr, adal + 2048, nullptr, nullptr};
                    pg8::gemm_phase<EpiRes<true>, pg8::StaticOrder>(lds, g, S, E, tid); }
                else { EpiRes<false> E{nullptr, nullptr, YB, STATS, p.in(21) + (size_t)(l * 2 - 1) * 1024, p.in(22) + (size_t)(l * 2 - 1) * 1024, adal + 2048, nullptr, nullptr};
                    pg8::gemm_phase<EpiRes<false>, pg8::StaticOrder>(lds, g, S, E, tid); }
            } else if (EN(7) && sub == 3) {
                ln_pass<1>(X, nullptr, nullptr, YB, STATS, nullptr, U2, p.in(21) + (size_t)(l * 2) * 1024, p.in(22) + (size_t)(l * 2) * 1024, adal + 3072, adal + 4096);
            } else if (EN(8) && sub == 4) {
                pg8::Gemm g{U2, (const bf16_t*)(wset + (OFF_WUP - OFF_W)), T, 5632, 1024, 1024, 1024}; pg8::StaticOrder S; S.init(T, 5632, G, c, 1024);
                EpiUpConv E{(bf16_t*)(p.ws() + OFF_R1), (float*)(p.ws() + OFF_EDGE), p.in(18) + (size_t)l * 3 * DFF, p.in(19) + (size_t)l * DFF, (LAS float*)(lds + HALO_OFF)};
                pg8::gemm_phase<EpiUpConv, pg8::StaticOrder>(lds, g, S, E, tid);
            } else if (EN(10) && sub == 5) {
                ffn_fix(p, X, l);
                pg8::Gemm g{(const bf16_t*)(p.ws() + OFF_R1), (const bf16_t*)(wset + (OFF_WDN - OFF_W)), T, 1024, 2816, 2816, 2816}; pg8::SplitOrder S; S.init(T, 1024, G, c, 2816);
                EpiRes<false, true> E{nullptr, nullptr, YB, STATS, p.in(21) + (size_t)(l * 2) * 1024, p.in(22) + (size_t)(l * 2) * 1024, adal + 5120,
                                      (float*)(p.ws() + OFF_R2), (unsigned*)(p.ws() + OFF_BAR + 16384) + l * 512};
                pg8::gemm_phase<EpiRes<false, true>, pg8::SplitOrder>(lds, g, S, E, tid);
                if (l < 3) {
                    const int n2 = G == 256 ? 128 : ((T / 256) * 4 > G ? (T / 256) * 4 - G : 0);
                    if (G - n2 >= 64) { if (c >= n2) convert_weights(p, tid, c - n2, G - n2, l + 1, lds, p.ws() + (((l + 1) & 1) ? OFF_W2 : OFF_W)); }
                    else convert_weights(p, tid, c, G, l + 1, lds, p.ws() + (((l + 1) & 1) ? OFF_W2 : OFF_W));
                }
            } else if (EN(11) && sub == 6) {
                const float* lg = p.in(21) + (size_t)(l * 2 + 1) * 1024; const float* lb = p.in(22) + (size_t)(l * 2 + 1) * 1024;
                if (l == 3) ln_pass<2>(X, nullptr, nullptr, YB, STATS, p.out(), nullptr, lg, lb, nullptr, nullptr);
                else ln_pass<1>(X, nullptr, nullptr, YB, STATS, nullptr, UM, lg, lb, adal + 9 * 6144 + 0, adal + 9 * 6144 + 1024);
            }
        }
        if (ph + 1 < ph_hi) { if (ph_hi < 0) grid.sync(); else xcd_barrier(xbar); }
        if (PROBE_CATS) {
            const int sub_ = ph < 2 ? -1 : (ph - 2) % NSUB, l_ = ph < 2 ? 0 : (ph - 2) / NSUB;
            const int cat = ph == 0 ? 0 : ph == 1 ? 1 : sub_ == 0 ? 2 : sub_ == 1 ? ((l_ & 1) ? 4 : 3) : sub_ == 2 ? 5 : (sub_ == 3 || sub_ == 6) ? 1 : sub_ == 4 ? 6 : 8;
            const unsigned long long now = __builtin_amdgcn_s_memrealtime();
            if ((PROBE_CATS >> cat) & 1) pr_acc += now - pr_prev;
            pr_prev = now;
        }
    }
    if (PROBE_CATS && blockIdx.x == 0) {
        const unsigned long long t0 = __builtin_amdgcn_s_memrealtime();
        while (__builtin_amdgcn_s_memrealtime() - t0 < pr_acc) __builtin_amdgcn_s_sleep(8);
    }
}

extern "C" void kernel_launch(void* const* d_in, const int* in_sizes, int n_in, void* d_out, int out_size, void* d_ws, size_t ws_size, hipStream_t stream) {
    static int grid = 0;
    if (grid == 0) {
        int dev = 0, cus = 0, per_cu = 0;
        (void)hipGetDevice(&dev);
        (void)hipDeviceGetAttribute(&cus, hipDeviceAttributeMultiprocessorCount, dev);
        (void)hipFuncSetAttribute((const void*)mk_fwd, hipFuncAttributeMaxDynamicSharedMemorySize, LDS_BYTES);
        (void)hipOccupancyMaxActiveBlocksPerMultiprocessor(&per_cu, (const void*)mk_fwd, 512, LDS_BYTES);
        if (per_cu < 1) { fprintf(stderr, "kernel_launch: occupancy query reports %d blocks per CU\n", per_cu); per_cu = 1; }
        (void)hipGetLastError();
        grid = cus;
        if (n_in != 23 || ws_size < WS_END) { fprintf(stderr, "kernel_launch: n_in %d ws %zu (need %zu)\n", n_in, ws_size, (size_t)WS_END); }
    }
    Params p{};
    for (int i = 0; i < 23; ++i) p.in[i] = (const float*)d_in[i];
    p.out = (float*)d_out; p.ws = (unsigned char*)d_ws;
#if MULTI_LAUNCH
    for (int ph = 0; ph < NPH; ++ph) { p.ph_lo = ph; p.ph_hi = ph + 1; hipLaunchKernelGGL(mk_fwd, dim3(grid), dim3(512), LDS_BYTES, stream, p); }
#else
    p.ph_lo = 0; p.ph_hi = NPH;
    (void)hipMemsetAsync((unsigned char*)d_ws + OFF_BAR, 0, 16384 + 8192 + 12288, stream);
    void* args[] = {&p};
    hipError_t e = hipLaunchCooperativeKernel((const void*)mk_fwd, dim3(grid), dim3(512), args, LDS_BYTES, stream);
    if (e != hipSuccess) fprintf(stderr, "cooperative launch failed: %s (grid %d)\n", hipGetErrorString(e), grid);
#endif
}
```
